# Optimizing an MI355X kernel written in HIP

```python
import math
import jax, jax.numpy as jnp
from jax import lax
import numpy as np

D_MODEL = 1024
BATCH = 8
SEQ = 4096
DEPTH = 2

CHUNK = 64
LOOKBACK_CHUNKS = 8
Q_BLOCK = 128
HEAD_DIM = 64
N_HEADS_A = 8
N_HEADS_B = 8
WIDTH_A = N_HEADS_A * HEAD_DIM
WIDTH_B = N_HEADS_B * HEAD_DIM
REL_CLIP = 128
N_IN = 3 * WIDTH_A + 3 * WIDTH_B + N_HEADS_B + 2 * D_MODEL
_SPLITS = list(np.cumsum([WIDTH_A, WIDTH_A, WIDTH_A, WIDTH_B, WIDTH_B, WIDTH_B,
                          N_HEADS_B, D_MODEL])[:].astype(int))
N_EXPERTS = 64
TOP_K = 8
N_GROUPS = 8
TOPK_GROUPS = 4
EXPERT_FF = 256
SHARED_FF = 256
ROUTED_SCALE = 2.5
EXPERT_BLOCK = 256
EPS = 1e-6
NEG_INF = -1e30

kernel_name = "hybrid_chunked_fox_moe_adaln_trunk"


def rms_norm(x, g):
    xf = x.astype(jnp.float32)
    y = xf * lax.rsqrt(jnp.mean(xf * xf, axis=-1, keepdims=True) + EPS)
    return (y * g.astype(jnp.float32)).astype(x.dtype)


def modulate(h, shift, scale):
    return h * (1.0 + scale[:, None, :]) + shift[:, None, :]


def chunk_band_attention(q, k, v, rel_table):
    B, H, S, dh = q.shape
    n_chunks = S // CHUNK
    pad = LOOKBACK_CHUNKS * CHUNK
    band = pad + CHUNK
    k_pad = jnp.pad(k, ((0, 0), (0, 0), (pad, 0), (0, 0)))
    v_pad = jnp.pad(v, ((0, 0), (0, 0), (pad, 0), (0, 0)))
    qi = jnp.arange(CHUNK)[:, None]
    kj = jnp.arange(band)[None, :]
    rel = qi + pad - kj
    bias = rel_table[:, jnp.clip(rel, -REL_CLIP, REL_CLIP) + REL_CLIP]
    bias = bias.astype(jnp.float32)
    scale = 1.0 / math.sqrt(dh)

    def one_chunk(n):
        start = n * CHUNK
        qn = lax.dynamic_slice_in_dim(q, start, CHUNK, axis=2)
        kn = lax.dynamic_slice_in_dim(k_pad, start, band, axis=2)
        vn = lax.dynamic_slice_in_dim(v_pad, start, band, axis=2)
        s = jnp.einsum('bhqd,bhkd->bhqk', qn, kn).astype(jnp.float32) * scale + bias
        valid = (start - pad + kj) >= 0
        p = jax.nn.softmax(jnp.where(valid, s, NEG_INF), axis=-1)
        return jnp.einsum('bhqk,bhkd->bhqd', p.astype(vn.dtype), vn)

    out = lax.map(one_chunk, jnp.arange(n_chunks))
    return out.transpose(1, 2, 0, 3, 4).reshape(B, H, S, dh)


def forgetting_attention(q, k, v, log_f):
    B, H, S, dh = q.shape
    cum = jnp.cumsum(log_f, axis=-1)
    scale = 1.0 / math.sqrt(dh)
    kpos = jnp.arange(S)[None, :]

    def one_block(i):
        start = i * Q_BLOCK
        qb = lax.dynamic_slice_in_dim(q, start, Q_BLOCK, axis=2)
        cq = lax.dynamic_slice_in_dim(cum, start, Q_BLOCK, axis=2)
        s = jnp.einsum('bhqd,bhkd->bhqk', qb, k).astype(jnp.float32) * scale
        s = s + cq[..., :, None] - cum[..., None, :]
        causal = kpos <= (start + jnp.arange(Q_BLOCK))[:, None]
        p = jax.nn.softmax(jnp.where(causal, s, NEG_INF), axis=-1)
        return jnp.einsum('bhqk,bhkd->bhqd', p.astype(v.dtype), v)

    out = lax.map(one_block, jnp.arange(S // Q_BLOCK))
    return out.transpose(1, 2, 0, 3, 4).reshape(B, H, S, dh)


def hybrid_mixer(h, w_in, b_fgate, qn_a, kn_a, qn_b, kn_b, rel_table, w_proj_a, w_proj_b, w_out):
    B, S, _ = h.shape
    z = h @ w_in
    qa, ka, va, qb, kb, vb, f_raw, ga, gb = jnp.split(z, _SPLITS, axis=-1)

    def heads(u):
        return u.reshape(B, S, -1, HEAD_DIM)

    def to_bhsd(u):
        return u.transpose(0, 2, 1, 3)

    qa = to_bhsd(rms_norm(heads(qa), qn_a))
    ka = to_bhsd(rms_norm(heads(ka), kn_a))
    qb = to_bhsd(rms_norm(heads(qb), qn_b))
    kb = to_bhsd(rms_norm(heads(kb), kn_b))
    ya = chunk_band_attention(qa, ka, to_bhsd(heads(va)), rel_table)
    log_f = jax.nn.log_sigmoid((f_raw + b_fgate).astype(jnp.float32)).transpose(0, 2, 1)
    yb = forgetting_attention(qb, kb, to_bhsd(heads(vb)), log_f)

    def merge_heads(y):
        return y.transpose(0, 2, 1, 3).reshape(B, S, -1)

    ua = merge_heads(ya) @ w_proj_a
    ub = merge_heads(yb) @ w_proj_b
    m = jax.nn.sigmoid(ga) * ua + jax.nn.sigmoid(gb) * ub
    return m @ w_out


def swiglu(t, wg, wu, wd):
    return (jax.nn.silu(t @ wg) * (t @ wu)) @ wd


def routed_experts(t, idx, w, wg, wu, wd):
    T, D = t.shape
    K = idx.shape[1]
    E = wg.shape[0]
    A = T * K
    G = EXPERT_BLOCK
    n_blocks = (A + G - 1) // G + E
    P = n_blocks * G
    flat_e = idx.reshape(-1)
    flat_tok = jnp.repeat(jnp.arange(T, dtype=jnp.int32), K)
    flat_w = w.reshape(-1)
    order = jnp.argsort(flat_e)
    se, stok, sw = flat_e[order], flat_tok[order], flat_w[order]
    counts = jnp.bincount(flat_e, length=E)
    starts = jnp.cumsum(counts) - counts
    padded = ((counts + G - 1) // G) * G
    pends = jnp.cumsum(padded)
    pstarts = pends - padded
    dest = pstarts[se] + (jnp.arange(A) - starts[se])
    buf_tok = jnp.full((P,), T, jnp.int32).at[dest].set(stok)
    buf_w = jnp.zeros((P,), flat_w.dtype).at[dest].set(sw)
    block_e = jnp.minimum(jnp.searchsorted(pends, jnp.arange(n_blocks) * G, side='right'), E - 1)
    t_pad = jnp.concatenate([t, jnp.zeros((1, D), t.dtype)], axis=0)

    def one_block(args):
        tok, e = args
        xb = t_pad[tok]
        return swiglu(xb, wg[e], wu[e], wd[e])

    out = lax.map(one_block, (buf_tok.reshape(n_blocks, G), block_e)).reshape(P, D)
    out = out * buf_w[:, None].astype(out.dtype)
    y = jnp.zeros((T + 1, D), out.dtype).at[buf_tok].add(out)[:T]
    return y.astype(t.dtype)


def moe_ffn(h, w_router, router_bias, wg, wu, wd, wgs, wus, wds):
    B, S, D = h.shape
    t = h.reshape(-1, D)
    T = t.shape[0]
    scores = jax.nn.sigmoid((t @ w_router).astype(jnp.float32))
    biased = scores + router_bias.astype(jnp.float32)
    per_group = N_EXPERTS // N_GROUPS
    grp = lax.top_k(biased.reshape(T, N_GROUPS, per_group), 2)[0].sum(-1)
    gidx = lax.top_k(grp, TOPK_GROUPS)[1]
    gmask = jnp.any(jnp.arange(N_GROUPS)[None, None, :] == gidx[:, :, None], axis=1)
    emask = jnp.repeat(gmask, per_group, axis=1)
    _, idx = lax.top_k(jnp.where(emask, biased, -jnp.inf), TOP_K)
    wsel = jnp.take_along_axis(scores, idx, axis=-1)
    wsel = wsel / jnp.sum(wsel, axis=-1, keepdims=True) * ROUTED_SCALE
    routed = routed_experts(t, idx, wsel, wg, wu, wd)
    shared = swiglu(t, wgs, wus, wds)
    return (routed + shared).reshape(B, S, D)


def setup_inputs(seed: int = 0) -> dict:
    key = jax.random.key(seed)
    ks = jax.random.split(key, 24)
    f32 = jnp.float32

    def nrm(k, shape, scale):
        return jax.random.normal(k, shape, f32) * scale

    L, D = DEPTH, D_MODEL
    return {
        "x": nrm(ks[0], (BATCH, SEQ, D), 1.0),
        "c": nrm(ks[1], (BATCH, D), 1.0),
        "ada_w": nrm(ks[2], (L, D, 6 * D), 0.5 * D ** -0.5),
        "ada_b": nrm(ks[3], (L, 6 * D), 0.02),
        "mix_norm_g": 1.0 + nrm(ks[4], (L, D), 0.05),
        "w_in": nrm(ks[5], (L, D, N_IN), D ** -0.5),
        "b_fgate": jax.random.uniform(ks[6], (L, N_HEADS_B), f32, 1.0, 4.0),
        "qn_a": 1.0 + nrm(ks[7], (L, HEAD_DIM), 0.05),
        "kn_a": 1.0 + nrm(ks[8], (L, HEAD_DIM), 0.05),
        "qn_b": 1.0 + nrm(ks[9], (L, HEAD_DIM), 0.05),
        "kn_b": 1.0 + nrm(ks[10], (L, HEAD_DIM), 0.05),
        "rel_bias": nrm(ks[11], (L, N_HEADS_A, 2 * REL_CLIP + 1), 0.5),
        "w_proj_a": nrm(ks[12], (L, WIDTH_A, D), WIDTH_A ** -0.5),
        "w_proj_b": nrm(ks[13], (L, WIDTH_B, D), WIDTH_B ** -0.5),
        "w_out": nrm(ks[14], (L, D, D), D ** -0.5),
        "ffn_norm_g": 1.0 + nrm(ks[15], (L, D), 0.05),
        "w_router": nrm(ks[16], (L, D, N_EXPERTS), D ** -0.5),
        "router_bias": nrm(ks[17], (L, N_EXPERTS), 0.01),
        "w_gate_e": nrm(ks[18], (L, N_EXPERTS, D, EXPERT_FF), D ** -0.5),
        "w_up_e": nrm(ks[19], (L, N_EXPERTS, D, EXPERT_FF), D ** -0.5),
        "w_down_e": nrm(ks[20], (L, N_EXPERTS, EXPERT_FF, D), EXPERT_FF ** -0.5),
        "w_gate_s": nrm(ks[21], (L, D, SHARED_FF), D ** -0.5),
        "w_up_s": nrm(ks[22], (L, D, SHARED_FF), D ** -0.5),
        "w_down_s": nrm(ks[23], (L, SHARED_FF, D), SHARED_FF ** -0.5),
    }


def reference(x, c, ada_w, ada_b, mix_norm_g, w_in, b_fgate, qn_a, kn_a, qn_b, kn_b, rel_bias,
              w_proj_a, w_proj_b, w_out, ffn_norm_g, w_router, router_bias,
              w_gate_e, w_up_e, w_down_e, w_gate_s, w_up_s, w_down_s):
    c_act = jax.nn.silu(c)
    for l in range(DEPTH):
        mod = c_act @ ada_w[l] + ada_b[l]
        sh1, sc1, g1, sh2, sc2, g2 = jnp.split(mod, 6, axis=-1)
        h = modulate(rms_norm(x, mix_norm_g[l]), sh1, sc1)
        x = x + g1[:, None, :] * hybrid_mixer(h, w_in[l], b_fgate[l], qn_a[l], kn_a[l], qn_b[l],
                                              kn_b[l], rel_bias[l], w_proj_a[l], w_proj_b[l],
                                              w_out[l])
        h = modulate(rms_norm(x, ffn_norm_g[l]), sh2, sc2)
        x = x + g2[:, None, :] * moe_ffn(h, w_router[l], router_bias[l], w_gate_e[l], w_up_e[l],
                                         w_down_e[l], w_gate_s[l], w_up_s[l], w_down_s[l])
    return x
```

```cpp
#include <hip/hip_runtime.h>
#include <hip/hip_bf16.h>
#include <cstdio>
#include <cstdint>
#include <cmath>
namespace pg8 {
#define PG8_LAS __attribute__((address_space(3)))
typedef unsigned short bf16_t;
typedef short bf16x8 __attribute__((ext_vector_type(8)));
typedef float f32x4 __attribute__((ext_vector_type(4)));
typedef float f32x2 __attribute__((ext_vector_type(2)));
typedef unsigned u32x4 __attribute__((ext_vector_type(4)));
constexpr int BM = 256, BK = 64, HALF = 128, HTB = HALF * BK * 2  , STAGE_BYTES = 8 * HTB, NXCD = 8, WGM = 8;

__host__ __device__ __forceinline__ int lds_byte(int r, int c) { const int st = (r >> 4) * 2 + (c >> 5), rr = r & 15, cc = c & 31, ob = rr * 64 + cc * 2; return st * 1024 + (ob ^ (((ob >> 9) & 1) << 5)); }
__host__ __device__ __forceinline__ void stage_rc(int b, int& R, int& C) { const int st = b / 1024, sb = b % 1024, swz = sb ^ (((sb >> 9) & 1) << 5); R = (st >> 1) * 16 + swz / 64; C = (st & 1) * 32 + (swz % 64) / 2; }
__host__ __device__ __forceinline__ int perm32(int rho) { const int n = rho >> 4, i = rho & 15; return 8 * (i >> 2) + 4 * n + (i & 3); }

struct Unit { int pm, pn, bt, aux; };

struct TileOrder {
    int nM, nN, nwg, G, c;
    __device__ __forceinline__ void init(int nM_, int nN_, int G_, int c_) { nM = nM_; nN = nN_; nwg = nM * nN; G = G_; c = c_; }
    __device__ __forceinline__ bool get(int i, int& pm, int& pn) const {
        const long L = (long)i * G + c; if (L >= nwg) return false;
        int wgid = (int)L; { const int q = nwg / NXCD, r = nwg % NXCD, xcd = wgid % NXCD, off = wgid / NXCD; wgid = (xcd < r ? xcd * (q + 1) : r * (q + 1) + (xcd - r) * q) + off; }
        const int nig = WGM * nN, gid = wgid / nig, fm = gid * WGM, gsz = (nM - fm) < WGM ? (nM - fm) : WGM;
        pm = fm + ((wgid % nig) % gsz); pn = (wgid % nig) / gsz; return true;
    }
};

__device__ __forceinline__ unsigned cvt_pk_bf16(float lo, float hi) { unsigned r; asm volatile("v_cvt_pk_bf16_f32 %0, %1, %2" : "=v"(r) : "v"(lo), "v"(hi)); return r; }
__device__ __forceinline__ float bf_lo(unsigned w) { return __uint_as_float(w << 16); }
__device__ __forceinline__ float bf_hi(unsigned w) { return __uint_as_float(w & 0xffff0000u); }

template <class Epi, class Sched>
__device__ __forceinline__ void gemm_phase(PG8_LAS unsigned char* lds, const void* Abase, const bf16_t* Bt, const int K, const Sched& S, const Epi& E) {
    int tid_ = threadIdx.x; asm volatile("" : "+v"(tid_));
    const int tid = tid_, wid = __builtin_amdgcn_readfirstlane(tid >> 6), lane = tid & 63, wr = wid >> 2, wc = wid & 3, fr = lane & 15, fq = lane >> 4;
    const int nt = K / BK;
    unsigned voffB[2];
#pragma unroll
    for (int i = 0; i < 2; ++i) { int R, C; stage_rc(tid * 16 + i * 8192, R, C); const int Rb = Epi::PERM ? ((R & ~31) + perm32(R & 31)) : R;
        voffB[i] = (unsigned)(Rb * K + C) * 2u; }
    const size_t kstep = (size_t)(BK * 2);
    const size_t hstep = (size_t)HALF * K * 2;
    const size_t tstep = 2 * hstep;
    const unsigned ldsw = (unsigned)wid * 1024u;
    const int aoff = lds_byte(wr * 64 + fr, fq * 8), boff = lds_byte(wc * 32 + fr, fq * 8);
#define PG8_SA(b, h) (((b) * 2 + (h)) * HTB)
#define PG8_SB(b, h) ((4 + (b) * 2 + (h)) * HTB)
#define PG8_STAGE(bufoff, gbase, voff) do { _Pragma("unroll") for (int _i = 0; _i < 2; ++_i) \
        __builtin_amdgcn_global_load_lds((const unsigned*)((const char*)(gbase) + (voff)[_i]), (PG8_LAS unsigned*)(lds + (bufoff) + ldsw + _i * 8192), 16, 0, 0); } while (0)
#define PG8_LDA(dst, b, h) do { _Pragma("unroll") for (int m = 0; m < 4; ++m) _Pragma("unroll") for (int k = 0; k < 2; ++k) dst[m][k] = *(const PG8_LAS bf16x8*)(lds + PG8_SA(b, h) + aoff + m * 2048 + k * 1024); } while (0)
#define PG8_LDB(dst, b, h) do { _Pragma("unroll") for (int n = 0; n < 2; ++n) _Pragma("unroll") for (int k = 0; k < 2; ++k) dst[n][k] = *(const PG8_LAS bf16x8*)(lds + PG8_SB(b, h) + boff + n * 2048 + k * 1024); } while (0)
#define PG8_MMA(ai, bj, At, Bt_) do { __builtin_amdgcn_s_setprio(1); _Pragma("unroll") for (int m = 0; m < 4; ++m) _Pragma("unroll") for (int n = 0; n < 2; ++n) _Pragma("unroll") for (int k = 0; k < 2; ++k) \
        acc[ai][bj][m][n] = __builtin_amdgcn_mfma_f32_16x16x32_bf16(Bt_[n][k], At[m][k], acc[ai][bj][m][n], 0, 0, 0); __builtin_amdgcn_s_setprio(0); } while (0)
#define PG8_WAIT_V(n) asm volatile("s_waitcnt vmcnt(" #n ")" ::: "memory")
#define PG8_WAIT_L(n) asm volatile("s_waitcnt lgkmcnt(" #n ")" ::: "memory")
#define PG8_BAR __builtin_amdgcn_s_barrier()
#define PG8_SCHED __builtin_amdgcn_sched_barrier(0)
#define PG8_VOFF(dst, u) do { _Pragma("unroll") for (int _i = 0; _i < 2; ++_i) { int _R, _C; stage_rc(tid * 16 + _i * 8192, _R, _C); _Pragma("unroll") for (int _h = 0; _h < 2; ++_h) dst[_h][_i] = S.a_off(u, _h * HALF + _R) + (unsigned)_C * 2u; } } while (0)
    Unit cur, nxt; int ui = 0;
    if (!S.next(0, cur)) return;
    f32x4 acc[2][2][4][2];
#pragma unroll
    for (int a = 0; a < 2; ++a)
#pragma unroll
        for (int b = 0; b < 2; ++b)
#pragma unroll
            for (int m = 0; m < 4; ++m)
#pragma unroll
                for (int n = 0; n < 2; ++n) acc[a][b][m][n] = (f32x4){0.f, 0.f, 0.f, 0.f};
    bf16x8 At[4][2], B0[2][2], B1[2][2];
    unsigned vc[2][2], vn[2][2];
    PG8_VOFF(vc, cur);
    const char* const Ab = (const char*)Abase;
    const char* cB = (const char*)Bt + (size_t)cur.bt * tstep;
    PG8_STAGE(PG8_SB(0, 0), cB, voffB); PG8_STAGE(PG8_SB(0, 1), cB + hstep, voffB); PG8_STAGE(PG8_SA(0, 0), Ab, vc[0]); PG8_STAGE(PG8_SA(0, 1), Ab, vc[1]);
    if (wr == 1) PG8_BAR;
    PG8_WAIT_V(2); PG8_BAR;
    PG8_STAGE(PG8_SB(1, 0), cB + kstep, voffB); PG8_STAGE(PG8_SA(1, 0), Ab + kstep, vc[0]); PG8_STAGE(PG8_SB(1, 1), cB + hstep + kstep, voffB);
    PG8_WAIT_V(6); PG8_BAR;
    for (;;) {
        const bool has_next = S.next(ui + 1, nxt);
        if (Sched::EARLY_VOFF) { if (has_next) { PG8_VOFF(vn, nxt); } else {
#pragma unroll
            for (int h = 0; h < 2; ++h)
#pragma unroll
                for (int i = 0; i < 2; ++i) vn[h][i] = vc[h][i]; } }
        const char* nB = has_next ? (const char*)Bt + (size_t)nxt.bt * tstep : cB;
#pragma unroll 1
        for (int t = 0; t < nt; t += 2) {
            const bool last = (t == nt - 2);
            const char* a1 = Ab + (size_t)(t + 1) * kstep;
            const char* a2 = last ? Ab : Ab + (size_t)(t + 2) * kstep; const char* b2 = last ? nB : cB + (size_t)(t + 2) * kstep;
            const char* a3 = a2 + kstep; const char* b3 = b2 + kstep;
            PG8_LDB(B0, 0, 0); PG8_LDB(B1, 0, 1); PG8_SCHED; PG8_LDA(At, 0, 0); PG8_STAGE(PG8_SA(1, 1), a1, vc[1]);
            if (last) { if (Sched::EARLY_VOFF) {
#pragma unroll
                for (int h = 0; h < 2; ++h)
#pragma unroll
                    for (int i = 0; i < 2; ++i) vc[h][i] = vn[h][i]; } else if (has_next) { PG8_VOFF(vc, nxt); } }
            PG8_WAIT_V(8); PG8_WAIT_L(0); PG8_BAR; PG8_MMA(0, 0, At, B0); PG8_MMA(0, 1, At, B1); PG8_BAR; PG8_SCHED;
            PG8_LDA(At, 0, 1); PG8_STAGE(PG8_SB(0, 0), b2, voffB); PG8_STAGE(PG8_SB(0, 1), b2 + hstep, voffB); PG8_STAGE(PG8_SA(0, 0), a2, vc[0]);
            PG8_WAIT_V(8); PG8_WAIT_L(0); PG8_BAR; PG8_MMA(1, 0, At, B0); PG8_MMA(1, 1, At, B1); PG8_BAR; PG8_SCHED;
            PG8_LDB(B0, 1, 0); PG8_LDB(B1, 1, 1); PG8_SCHED; PG8_LDA(At, 1, 0); PG8_STAGE(PG8_SA(0, 1), a2, vc[1]);
            PG8_WAIT_V(8); PG8_WAIT_L(0); PG8_BAR; PG8_MMA(0, 0, At, B0); PG8_MMA(0, 1, At, B1); PG8_BAR; PG8_SCHED;
            PG8_LDA(At, 1, 1); PG8_STAGE(PG8_SB(1, 0), b3, voffB); PG8_STAGE(PG8_SB(1, 1), b3 + hstep, voffB); PG8_STAGE(PG8_SA(1, 0), a3, vc[0]);
            PG8_WAIT_V(8); PG8_WAIT_L(0); PG8_BAR; PG8_MMA(1, 0, At, B0); PG8_MMA(1, 1, At, B1); PG8_BAR; PG8_SCHED;
        }
        if (wr == 0) PG8_BAR;
        E(acc, cur, wr, wc, fr, fq);
        if (!has_next) break;
#pragma unroll
        for (int a = 0; a < 2; ++a)
#pragma unroll
            for (int b = 0; b < 2; ++b)
#pragma unroll
                for (int m = 0; m < 4; ++m)
#pragma unroll
                    for (int n = 0; n < 2; ++n) acc[a][b][m][n] = (f32x4){0.f, 0.f, 0.f, 0.f};
        cur = nxt; cB = nB; ++ui;
        if (wr == 1) PG8_BAR;
    }
    PG8_WAIT_V(0);
    PG8_BAR;
#undef PG8_SA
#undef PG8_SB
#undef PG8_STAGE
#undef PG8_LDA
#undef PG8_LDB
#undef PG8_MMA
#undef PG8_WAIT_V
#undef PG8_WAIT_L
#undef PG8_BAR
#undef PG8_SCHED
#undef PG8_VOFF
}
}
namespace att {
#define ATT_LAS __attribute__((address_space(3)))
typedef unsigned short bf16_t;
using bf16x8 = __attribute__((ext_vector_type(8))) short;
using s16x4 = __attribute__((ext_vector_type(4))) short;
using f32x16 = __attribute__((ext_vector_type(16))) float;
using u32x4 = __attribute__((ext_vector_type(4))) unsigned;
typedef float f32x4 __attribute__((ext_vector_type(4)));
constexpr int PITCH = 512, SEQ = 4096, NH = 8, D = 64;
constexpr float LOG2E = 1.4426950408889634f;
constexpr int L_K = 0, L_V = 8192, L_BIAS = 16384, L_REL = 16640, L_WS = 17920, L_OST = 19968, LDS_BYTES = L_OST + 8 * 4096;
__device__ __forceinline__ int crow(int r, int hi) { return (r & 3) + 8 * (r >> 2) + 4 * hi; }
typedef float f32x2_t __attribute__((ext_vector_type(2))); typedef __bf16 bf16x2_t __attribute__((ext_vector_type(2)));
__device__ __forceinline__ unsigned cvtpk_s(float lo, float hi) { f32x2_t v = {lo, hi}; bf16x2_t b = __builtin_convertvector(v, bf16x2_t); return __builtin_bit_cast(unsigned, b); }
__device__ __forceinline__ unsigned short f2bf(float f) { unsigned u = __builtin_bit_cast(unsigned, f); return (unsigned short)((u + 0x7fffu + ((u >> 16) & 1u)) >> 16); }

template <int MODE>
__device__ __forceinline__ void attn_unit(int b, int h, int ub, const bf16_t* Q, const bf16_t* __restrict__ K, const bf16_t* __restrict__ V, bf16_t* O,
                                          const float* __restrict__ cum  , const float* __restrict__ rel  , ATT_LAS unsigned char* shm) {
    int tid_ = threadIdx.x; asm volatile("" : "+v"(tid_));
    const int tid = tid_, lane = tid & 63, r32 = lane & 31, hi = lane >> 5; const int wid = __builtin_amdgcn_readfirstlane(tid >> 6);
    const long rowbase = (long)b * SEQ; const int q0 = ub * 256;
    const bf16_t* Qw = Q + (rowbase + q0 + wid * 32) * PITCH + h * D;
    const bf16_t* Kh = K + rowbase * PITCH + h * D; const bf16_t* Vh = V + rowbase * PITCH + h * D;
    ATT_LAS float* biasl = (ATT_LAS float*)(shm + L_BIAS);
    ATT_LAS float* rell = (ATT_LAS float*)(shm + L_REL);
    ATT_LAS float* wsf = (ATT_LAS float*)(shm + L_WS) + wid * 64;
    int t_lo, t_hi, wt_lo, wt_hi;
    if (MODE == 0) { t_lo = 0; t_hi = (q0 + 256) / 64 - 1; wt_lo = 0; wt_hi = (q0 + wid * 32 + 31) / 64; }
    else { const int c = 4 * ub + (wid >> 1); wt_lo = c - 8 < 0 ? 0 : c - 8; wt_hi = c; t_lo = 4 * ub - 8 < 0 ? 0 : 4 * ub - 8; t_hi = 4 * ub + 3; }
    const float cq0 = (MODE == 0) ? cum[(b * NH + h) * SEQ + q0] : 0.f;
    bf16x8 qr[4];
#pragma unroll
    for (int d0 = 0; d0 < 4; ++d0) qr[d0] = *reinterpret_cast<const bf16x8*>(&Qw[(long)r32 * PITCH + d0 * 16 + hi * 8]);
    float mrun = -1e30f, lrun = 0.f; f32x16 o[2]; o[0] = f32x16{}; o[1] = f32x16{};
    const int qabs = q0 + wid * 32 + r32;
    const bf16_t* ksrc = Kh + (long)lane * PITCH + wid * 8;
    const bf16_t* vsrc = Vh + (long)(16 * (wid & 3) + (lane >> 2)) * PITCH + (wid >> 2) * 32 + (lane & 3) * 8;
    ATT_LAS unsigned char* kdst = shm + L_K + wid * 1024 + lane * 16;
    ATT_LAS unsigned char* vdst = shm + L_V + wid * 1024 + lane * 16;
    const unsigned vb0 = (unsigned)(uintptr_t)(shm + L_V) + ((lane >> 4) & 1) * 32 + (lane & 3) * 8 + (4 * hi + ((lane & 15) >> 2)) * 64;
    const ATT_LAS unsigned char* kb = shm + L_K + hi * 1024 + r32 * 16;
    __syncthreads();
    if (MODE == 1) { for (int i = tid; i < 257; i += 512) rell[i] = rel[h * 257 + i] * LOG2E; }
    u32x4 kreg = *(const u32x4*)(ksrc + (long)t_lo * 64 * PITCH), vreg = *(const u32x4*)(vsrc + (long)t_lo * 64 * PITCH);
    float cj = 0.f; if (MODE == 0 && wid == 0) cj = cum[(b * NH + h) * SEQ + t_lo * 64 + lane];
    for (int t = t_lo; t <= t_hi; ++t) {
        __syncthreads();
        *(ATT_LAS u32x4*)kdst = kreg; *(ATT_LAS u32x4*)vdst = vreg;
        if (MODE == 0 && wid == 0) biasl[lane] = (cq0 - cj) * LOG2E;
        if (t < t_hi) { kreg = *(const u32x4*)(ksrc + (long)(t + 1) * 64 * PITCH); vreg = *(const u32x4*)(vsrc + (long)(t + 1) * 64 * PITCH);
            if (MODE == 0 && wid == 0) cj = cum[(b * NH + h) * SEQ + (t + 1) * 64 + lane]; }
        __syncthreads();
        if (t >= wt_lo && t <= wt_hi) {
            f32x16 p0 = f32x16{}, p1 = f32x16{};
#pragma unroll
            for (int d0 = 0; d0 < 4; ++d0) {
                const bf16x8 b0 = *reinterpret_cast<const ATT_LAS bf16x8*>(kb + d0 * 2048);
                const bf16x8 b1 = *reinterpret_cast<const ATT_LAS bf16x8*>(kb + d0 * 2048 + 512);
                p0 = __builtin_amdgcn_mfma_f32_32x32x16_bf16(b0, qr[d0], p0, 0, 0, 0); p1 = __builtin_amdgcn_mfma_f32_32x32x16_bf16(b1, qr[d0], p1, 0, 0, 0); }
            if (MODE == 0) {
#pragma unroll
                for (int g = 0; g < 4; ++g) { const f32x4 bA = *(const ATT_LAS f32x4*)(biasl + 8 * g + 4 * hi), bB = *(const ATT_LAS f32x4*)(biasl + 32 + 8 * g + 4 * hi);
#pragma unroll
                    for (int i = 0; i < 4; ++i) { const int r = 4 * g + i; const int kv = 64 * t + 8 * g + 4 * hi + i;
                        p0[r] = (kv > qabs) ? -INFINITY : p0[r] + bA[i]; p1[r] = (kv + 32 > qabs) ? -INFINITY : p1[r] + bB[i]; } }
            } else {
#pragma unroll
                for (int r = 0; r < 16; ++r) { const int kv = 64 * t + crow(r, hi); int d0_ = qabs - kv; int d1_ = d0_ - 32;
                    d0_ = d0_ < -128 ? -128 : (d0_ > 128 ? 128 : d0_); d1_ = d1_ < -128 ? -128 : (d1_ > 128 ? 128 : d1_);
                    p0[r] += rell[d0_ + 128]; p1[r] += rell[d1_ + 128]; }
            }
            float rm = p0[0];
#pragma unroll
            for (int r = 1; r < 16; ++r) rm = fmaxf(rm, p0[r]);
#pragma unroll
            for (int r = 0; r < 16; ++r) rm = fmaxf(rm, p1[r]);
            rm = fmaxf(rm, __shfl_xor(rm, 32));
            const float mnew = fmaxf(mrun, rm); const float alpha = __builtin_amdgcn_exp2f(mrun - mnew); mrun = mnew;
            float sacc = 0.f;
#pragma unroll
            for (int r = 0; r < 16; ++r) { p0[r] = __builtin_amdgcn_exp2f(p0[r] - mnew); p1[r] = __builtin_amdgcn_exp2f(p1[r] - mnew); sacc += p0[r] + p1[r]; }
            lrun = lrun * alpha + sacc;
            if (hi == 0) wsf[r32] = alpha;
            asm volatile("s_waitcnt lgkmcnt(0)" ::: "memory");
#pragma unroll
            for (int r = 0; r < 16; ++r) { const float f = wsf[crow(r, hi)]; o[0][r] *= f; o[1][r] *= f; }
            u32x4 pw0, pw1, pw2, pw3;
            pw0 = (u32x4){cvtpk_s(p0[0], p0[1]), cvtpk_s(p0[2], p0[3]), cvtpk_s(p0[4], p0[5]), cvtpk_s(p0[6], p0[7])};
            pw1 = (u32x4){cvtpk_s(p0[8], p0[9]), cvtpk_s(p0[10], p0[11]), cvtpk_s(p0[12], p0[13]), cvtpk_s(p0[14], p0[15])};
            pw2 = (u32x4){cvtpk_s(p1[0], p1[1]), cvtpk_s(p1[2], p1[3]), cvtpk_s(p1[4], p1[5]), cvtpk_s(p1[6], p1[7])};
            pw3 = (u32x4){cvtpk_s(p1[8], p1[9]), cvtpk_s(p1[10], p1[11]), cvtpk_s(p1[12], p1[13]), cvtpk_s(p1[14], p1[15])};
            const bf16x8 pa0 = __builtin_bit_cast(bf16x8, pw0), pa1 = __builtin_bit_cast(bf16x8, pw1), pa2 = __builtin_bit_cast(bf16x8, pw2), pa3 = __builtin_bit_cast(bf16x8, pw3);
#pragma unroll
            for (int d0 = 0; d0 < 2; ++d0) { s16x4 lo[4], hh[4];
#pragma unroll
                for (int ks = 0; ks < 4; ++ks) {
                    asm volatile("ds_read_b64_tr_b16 %0,%1 offset:%c2" : "=&v"(lo[ks]) : "v"(vb0), "i"(d0 * 4096 + ks * 1024) : "memory");
                    asm volatile("ds_read_b64_tr_b16 %0,%1 offset:%c2" : "=&v"(hh[ks]) : "v"(vb0), "i"(d0 * 4096 + ks * 1024 + 512) : "memory"); }
                asm volatile("s_waitcnt lgkmcnt(0)" ::: "memory"); __builtin_amdgcn_sched_barrier(0);
#define ATT_PK(k) (bf16x8){lo[k][0], lo[k][1], lo[k][2], lo[k][3], hh[k][0], hh[k][1], hh[k][2], hh[k][3]}
                o[d0] = __builtin_amdgcn_mfma_f32_32x32x16_bf16(pa0, ATT_PK(0), o[d0], 0, 0, 0);
                o[d0] = __builtin_amdgcn_mfma_f32_32x32x16_bf16(pa1, ATT_PK(1), o[d0], 0, 0, 0);
                o[d0] = __builtin_amdgcn_mfma_f32_32x32x16_bf16(pa2, ATT_PK(2), o[d0], 0, 0, 0);
                o[d0] = __builtin_amdgcn_mfma_f32_32x32x16_bf16(pa3, ATT_PK(3), o[d0], 0, 0, 0);
#undef ATT_PK
            }
        }
    }
    lrun += __shfl_xor(lrun, 32);
    if (hi == 0) wsf[32 + r32] = lrun;
    asm volatile("s_waitcnt lgkmcnt(0)" ::: "memory");
    float rli[16];
#pragma unroll
    for (int r = 0; r < 16; ++r) rli[r] = 1.0f / wsf[32 + crow(r, hi)];
    bf16_t* Ow = O + (rowbase + q0 + wid * 32) * PITCH + h * D;
    { ATT_LAS bf16_t* stg = (ATT_LAS bf16_t*)(shm + L_OST) + wid * 2048;
#pragma unroll
      for (int r = 0; r < 16; ++r) { const int orow = crow(r, hi);
#pragma unroll
          for (int d0 = 0; d0 < 2; ++d0) stg[orow * 64 + d0 * 32 + r32] = f2bf(o[d0][r] * rli[r]); }
      asm volatile("s_waitcnt lgkmcnt(0)" ::: "memory");
#pragma unroll
      for (int i = 0; i < 4; ++i) { const int row = i * 8 + (lane >> 3), ch = lane & 7; const u32x4 v = *(const ATT_LAS u32x4*)(stg + row * 64 + ch * 8); *(u32x4*)(Ow + (long)row * PITCH + ch * 8) = v; } }
}
}
constexpr int NWAVES = 8;
constexpr int T = 32768, D = 1024, NBATCH = 8, SEQ = 4096, DEPTH = 2, NIN = 5128, NE = 64, FF = 256;
constexpr int CH_TOK = 16384, NCHUNK = 2, RMAX = 163840, NSLOT = 9;
constexpr float EPS = 1e-6f;
constexpr float C2 = 0.125f * 1.4426950408889634f;
constexpr size_t MiB = 1u << 20;
constexpr size_t WS_CTL = 0, CTL_ZERO_BYTES = 1 * MiB;
constexpr size_t WS_MOD = 1 * MiB;
constexpr size_t WS_GAIN = 1 * MiB + 512 * 1024;
constexpr size_t WS_LOGF = 2 * MiB;
constexpr size_t WS_CUM = 3 * MiB;
constexpr size_t WS_RIDX = 4 * MiB;
constexpr size_t WS_RW = 5 * MiB;
constexpr size_t WS_CNT = 6 * MiB;
constexpr size_t WS_META = 6 * MiB + 65536;
constexpr size_t WS_RTOK = 7 * MiB;
constexpr size_t WS_RWT = 9 * MiB;
constexpr size_t WS_RDST = 11 * MiB;
constexpr size_t WS_LOGIT = 13 * MiB;
constexpr size_t WS_WIN = 22 * MiB;
constexpr size_t WS_WPROJ = 32 * MiB;
constexpr size_t WS_WOUT = 34 * MiB;
constexpr size_t WS_WR = 36 * MiB;
constexpr size_t WS_WGU = 37 * MiB;
constexpr size_t WS_WD = 102 * MiB;
constexpr size_t WS_H = 135 * MiB;
constexpr size_t WS_QKV = 200 * MiB;
constexpr size_t QKV_STRIDE = (size_t)T * 512;
constexpr size_t WS_G = 392 * MiB;
constexpr size_t G_STRIDE = (size_t)T * 1024;
constexpr size_t WS_ACT = 200 * MiB;
constexpr size_t WS_SLOT = 280 * MiB;
constexpr size_t WS_END = 568 * MiB;
static_assert(WS_SLOT + (size_t)CH_TOK * NSLOT * 1024 * 2 <= WS_END && WS_ACT + (size_t)RMAX * 256 * 2 <= WS_SLOT && WS_G + 2 * G_STRIDE * 2 <= WS_END && WS_QKV + 6 * QKV_STRIDE * 2 <= WS_G, "ws map");
constexpr int CW_BAR = 4096;
constexpr int RING_BYTES = 131072, LDSCTL_OFF = RING_BYTES, MISC_OFF = LDSCTL_OFF + 320, LDS_BYTES = 147456;

#define GAS __attribute__((address_space(1)))
#define LAS __attribute__((address_space(3)))
typedef unsigned short bf16;
typedef unsigned v4u __attribute__((ext_vector_type(4)));
typedef unsigned v2u __attribute__((ext_vector_type(2)));
typedef float f32x4 __attribute__((ext_vector_type(4)));
#define LDS_WAIT() asm volatile("s_waitcnt lgkmcnt(0)" ::: "memory")
__device__ __forceinline__ unsigned f2bf(float f) { unsigned u = __builtin_bit_cast(unsigned, f); return (u + 0x7fffu + ((u >> 16) & 1u)) >> 16; }
__device__ __forceinline__ unsigned pk2(float lo, float hi) { return f2bf(lo) | (f2bf(hi) << 16); }
__device__ __forceinline__ float bflo(unsigned w) { return __uint_as_float(w << 16); }
__device__ __forceinline__ float bfhi(unsigned w) { return __uint_as_float(w & 0xffff0000u); }
__device__ __forceinline__ float sigmoidf_(float x) { return 1.0f / (1.0f + __expf(-x)); }

#define XB_TMO      128
#define XB_XCNT(j)  (256  + 64 * (j))
#define XB_XSUB(j)  (1280 + 64 * (j))
#define XB_XGEN(j)  (2304 + 64 * (j))
#define XB_TOP      3328
#define XB_TOPGEN   3392
#define XCD_BAR_WORDS 3456
#define XB_SPIN_CAP (1u << 18)
__device__ __forceinline__ unsigned xb_ld(unsigned* p)              { return __hip_atomic_load(p, __ATOMIC_RELAXED, __HIP_MEMORY_SCOPE_AGENT); }
__device__ __forceinline__ unsigned xb_add(unsigned* p, unsigned v) { return __hip_atomic_fetch_add(p, v, __ATOMIC_RELAXED, __HIP_MEMORY_SCOPE_AGENT); }
__device__ __forceinline__ unsigned xb_xcc_id() { return (unsigned)__builtin_amdgcn_s_getreg((3 << 11) | 20) & 0xFu; }
#define XB_SPIN(cond, bar) do { unsigned _sp = 0; while (cond) { __builtin_amdgcn_s_sleep(1); \
    if ((++_sp & 255u) == 0u) { if (xb_ld(&(bar)[XB_TMO])) break; if (_sp > XB_SPIN_CAP) { atomicAdd(&(bar)[XB_TMO], 1u); break; } } } } while (0)
struct XcdBarrier { unsigned* bar; unsigned x; volatile LAS unsigned* st; };
__device__ __forceinline__ XcdBarrier xcd_barrier_post(unsigned* bar, volatile LAS unsigned* st) {
    XcdBarrier b; b.bar = bar; b.x = xb_xcc_id(); b.st = st;
    if (threadIdx.x == 0) (void)xb_add(&bar[XB_XCNT(b.x)], 1u);
    return b;
}
__device__ __forceinline__ void xcd_barrier_complete(unsigned* bar, unsigned x, unsigned& nloc, unsigned& nx) {
    const unsigned G = gridDim.x * gridDim.y * gridDim.z;
    unsigned sum, cnt, mine, sp = 0u;
    for (;;) {
        sum = 0u; cnt = 0u; mine = 0u;
#pragma unroll
        for (unsigned j = 0; j < 16; ++j) { const unsigned c = xb_ld(&bar[XB_XCNT(j)]); sum += c; cnt += (c > 0u) ? 1u : 0u; mine = (j == x) ? c : mine; }
        if (sum == G) break;
        __builtin_amdgcn_s_sleep(1);
        if ((++sp & 255u) == 0u) { if (xb_ld(&bar[XB_TMO])) break; if (sp > XB_SPIN_CAP) { atomicAdd(&bar[XB_TMO], 1u); break; } }
    }
    nloc = mine > 0u ? mine : 1u; nx = cnt > 0u ? cnt : 1u;
}
__device__ __forceinline__ void xcd_barrier(const XcdBarrier& b) {
    asm volatile("s_waitcnt vmcnt(0)" ::: "memory");
    __syncthreads();
    if (threadIdx.x == 0) {
        unsigned* bar = b.bar;
        __builtin_amdgcn_s_waitcnt(0);
        unsigned nloc = b.st[0], nx = b.st[1];
        if (nloc == 0u) { xcd_barrier_complete(bar, b.x, nloc, nx); b.st[0] = nloc; b.st[1] = nx; }
        const unsigned old = xb_add(&bar[XB_XSUB(b.x)], 1u);
        const unsigned gen = old / nloc;
        if (old + 1u == (gen + 1u) * nloc) {
            __builtin_amdgcn_fence(__ATOMIC_RELEASE, "agent");
            asm volatile("s_waitcnt vmcnt(0)" ::: "memory");
            const unsigned og = xb_add(&bar[XB_TOP], 1u);
            const unsigned tg = og / nx;
            if (og + 1u == (tg + 1u) * nx) xb_add(&bar[XB_TOPGEN], 1u);
            else XB_SPIN(xb_ld(&bar[XB_TOPGEN]) == tg, bar);
            __builtin_amdgcn_fence(__ATOMIC_ACQUIRE, "agent");
            xb_add(&bar[XB_XGEN(b.x)], 1u);
            asm volatile("s_waitcnt vmcnt(0)" ::: "memory");
        } else {
            XB_SPIN(xb_ld(&bar[XB_XGEN(b.x)]) == gen, bar);
            __builtin_amdgcn_fence(__ATOMIC_ACQUIRE, "agent");
            asm volatile("s_waitcnt vmcnt(0)" ::: "memory");
        }
    }
    __syncthreads();
}

__device__ __forceinline__ float wave_sum(float v) {
#pragma unroll
    for (int o = 1; o < 64; o <<= 1) v += __shfl_xor(v, o);
    return v;
}
__device__ __forceinline__ void transpose_item(const float* __restrict__ W, int ldw, int col0, int k0, bf16* WT, int ldt, int drow0, LAS float* scr, int lane) {
#pragma unroll 8
    for (int i = 0; i < 32; ++i) { const int kk = 2 * i + (lane >> 5); scr[kk * 33 + (lane & 31)] = W[(size_t)(k0 + kk) * ldw + col0 + (lane & 31)]; }
    LDS_WAIT(); asm volatile("" ::: "memory");
    const int c = lane & 7;
#pragma unroll
    for (int j = 0; j < 4; ++j) { const int n = (lane >> 3) + 8 * j; const LAS float* s = scr + (8 * c) * 33 + n;
        v4u o; o.x = pk2(s[0 * 33], s[1 * 33]); o.y = pk2(s[2 * 33], s[3 * 33]); o.z = pk2(s[4 * 33], s[5 * 33]); o.w = pk2(s[6 * 33], s[7 * 33]);
        *(v4u*)(WT + (size_t)(drow0 + n) * ldt + k0 + 8 * c) = o; }
    LDS_WAIT(); asm volatile("" ::: "memory");
}

struct Args { const float* in[24]; float* out; unsigned char* ws; };
struct ArgView {
    __device__ __forceinline__ const float* operator[](int k) const { asm volatile("" : "+s"(k)); return ((const float* const __attribute__((address_space(4)))*)__builtin_amdgcn_kernarg_segment_ptr())[k]; } };
struct ArgsV { ArgView in;
    __device__ __forceinline__ float* outp() const { return (float*)in[24]; }
    __device__ __forceinline__ unsigned char* wsp() const { return (unsigned char*)in[25]; } };

enum { I_X = 0, I_C, I_ADAW, I_ADAB, I_MIXG, I_WIN, I_BF, I_QNA, I_KNA, I_QNB, I_KNB, I_REL, I_WPA, I_WPB, I_WOUT, I_FFNG, I_WR, I_RB, I_WGE, I_WUE, I_WDE, I_WGS, I_WUS, I_WDS };

__device__ __forceinline__ void convert_weights(const ArgsV& a, int l, LAS unsigned char* lds, int gw, int NGW, int wave, int lane) {
    LAS float* scr = (LAS float*)(lds + wave * 8448);
    unsigned char* ws = a.wsp();
    constexpr int I_IN = 2560, I_PA = 256, I_PB = 256, I_OUT = 512, I_R = 32, I_GU = 65 * 256, I_DN = 65 * 128;
    constexpr int NITEMS = I_IN + I_PA + I_PB + I_OUT + I_R + I_GU + I_DN;
    for (int it = gw; it < NITEMS; it += NGW) {
        int r = it;
        if (r < I_IN) { const int kb = r / 160, nb = r % 160, pn = nb >> 3, g = nb & 7, lc0 = 64 * (g & 3) + 32 * (g >> 2);
            const int zc0 = pn < 12 ? 256 * pn + lc0 : 3080 + 256 * (pn - 12) + lc0;
            transpose_item(a.in[I_WIN] + (size_t)l * D * NIN, NIN, zc0, 64 * kb, (bf16*)(ws + WS_WIN), 1024, 32 * nb, scr, lane); continue; }
        r -= I_IN;
        if (r < I_PA) { const int kb = r / 32, nb = r % 32; transpose_item(a.in[I_WPA] + (size_t)l * 512 * 1024, 1024, 32 * nb, 64 * kb, (bf16*)(ws + WS_WPROJ), 512, 32 * nb, scr, lane); continue; }
        r -= I_PA;
        if (r < I_PB) { const int kb = r / 32, nb = r % 32; transpose_item(a.in[I_WPB] + (size_t)l * 512 * 1024, 1024, 32 * nb, 64 * kb, (bf16*)(ws + WS_WPROJ), 512, 1024 + 32 * nb, scr, lane); continue; }
        r -= I_PB;
        if (r < I_OUT) { const int kb = r / 32, nb = r % 32; transpose_item(a.in[I_WOUT] + (size_t)l * 1024 * 1024, 1024, 32 * nb, 64 * kb, (bf16*)(ws + WS_WOUT), 1024, 32 * nb, scr, lane); continue; }
        r -= I_OUT;
        if (r < I_R) { const int kb = r / 2, nb = r % 2; transpose_item(a.in[I_WR] + (size_t)l * 1024 * 64, 64, 32 * nb, 64 * kb, (bf16*)(ws + WS_WR), 1024, 32 * nb, scr, lane); continue; }
        r -= I_R;
        if (r < I_GU) { const int e = r >> 8, r1 = r & 255, mat = r1 >> 7, r2 = r1 & 127, kb = r2 >> 3, nb = r2 & 7;
            const float* src = e < 64 ? a.in[mat ? I_WUE : I_WGE] + ((size_t)l * 64 + e) * 262144 : a.in[mat ? I_WUS : I_WGS] + (size_t)l * 262144;
            transpose_item(src, 256, 32 * nb, 64 * kb, (bf16*)(ws + WS_WGU), 1024, e * 512 + 256 * (nb >> 2) + 128 * mat + 32 * (nb & 3), scr, lane); continue; }
        r -= I_GU;
        { const int e = r >> 7, r1 = r & 127, kb = r1 >> 5, nb = r1 & 31;
            const float* src = e < 64 ? a.in[I_WDE] + ((size_t)l * 64 + e) * 262144 : a.in[I_WDS] + (size_t)l * 262144;
            transpose_item(src, 1024, 32 * nb, 64 * kb, (bf16*)(ws + WS_WD), 256, e * 1024 + 32 * nb, scr, lane); }
    }
}

__device__ __forceinline__ void mod_unit(const ArgsV& a, int u, LAS unsigned char* lds, int tid, int wave, int lane) {
    LAS float* cact = (LAS float*)(lds + 73728);
    LAS float* part = (LAS float*)(lds + 73728 + 32768);
    for (int i = tid; i < 8192; i += 512) { const float c = a.in[I_C][i]; cact[i] = c * sigmoidf_(c); }
    __syncthreads();
    const int l = u / 96, cg = u % 96;
    const float* W = a.in[I_ADAW] + (size_t)l * D * 6144 + 64 * cg + lane;
    float acc[8];
#pragma unroll
    for (int b = 0; b < 8; ++b) acc[b] = 0.f;
    for (int k = 128 * wave; k < 128 * wave + 128; ++k) { const float wv = W[(size_t)k * 6144];
#pragma unroll
        for (int b = 0; b < 8; ++b) acc[b] += cact[b * 1024 + k] * wv; }
#pragma unroll
    for (int b = 0; b < 8; ++b) part[(wave * 8 + b) * 64 + lane] = acc[b];
    __syncthreads();
    { const int b = tid >> 6; float s = 0.f;
#pragma unroll
      for (int w = 0; w < 8; ++w) s += part[(w * 8 + b) * 64 + lane];
      ((float*)(a.wsp() + WS_MOD))[(size_t)(l * 8 + b) * 6144 + 64 * cg + lane] = s + a.in[I_ADAB][l * 6144 + 64 * cg + lane]; }
    __syncthreads();
}

__device__ __forceinline__ void reduce_rows(const ArgsV& a, int l, int row_lo, int row_hi, int chunk_row0, int gw, int NGW, int lane) {
    const float* mod = (const float*)(a.wsp() + WS_MOD);
    const bf16* slots = (const bf16*)(a.wsp() + WS_SLOT);
    for (int m = row_lo + gw; m < row_hi; m += NGW) {
        const int b = m >> 12;
        const float* g2 = mod + (size_t)(l * 8 + b) * 6144 + 5120;
        float* xr = a.outp() + (size_t)m * D;
#pragma unroll
        for (int jj = 0; jj < 4; ++jj) { const int c = 4 * lane + 256 * jj;
            f32x4 s = (f32x4){0.f, 0.f, 0.f, 0.f};
#pragma unroll
            for (int k = 0; k < NSLOT; ++k) { const v2u w = *(const v2u*)(slots + ((size_t)(m - chunk_row0) * NSLOT + k) * 1024 + c); s.x += bflo(w.x); s.y += bfhi(w.x); s.z += bflo(w.y); s.w += bfhi(w.y); }
            const f32x4 g = *(const f32x4*)(g2 + c); f32x4 x = *(const f32x4*)(xr + c); x = x + g * s; *(f32x4*)(xr + c) = x; }
    }
}

template <int WHICH>
__device__ __forceinline__ void norm_rows(const ArgsV& a, int l, LAS unsigned char* lds, int gw, int lane) {
    const float* mod = (const float*)(a.wsp() + WS_MOD);
    bf16* H = (bf16*)(a.wsp() + WS_H);
    const LAS float* wfl = (const LAS float*)(lds + 73728);
    const int m0 = 16 * gw, b = m0 >> 12;
    const float* gsrc = a.in[WHICH == 0 ? I_MIXG : I_FFNG] + l * D;
    const float* sh = mod + (size_t)(l * 8 + b) * 6144 + (WHICH == 0 ? 0 : 3072);
    const float* sc = sh + 1024;
    f32x4 gA[4], gB[4];
#pragma unroll
    for (int jj = 0; jj < 4; ++jj) { const int c = 4 * lane + 256 * jj; const f32x4 g = *(const f32x4*)(gsrc + c), s = *(const f32x4*)(sc + c); gA[jj] = g * (s + 1.0f); gB[jj] = *(const f32x4*)(sh + c); }
    const float* xsrc = (WHICH == 0 && l == 0) ? a.in[I_X] : a.outp();
#pragma unroll 1
    for (int r = 0; r < 16; ++r) { const int m = m0 + r;
        f32x4 v[4];
#pragma unroll
        for (int jj = 0; jj < 4; ++jj) v[jj] = *(const f32x4*)(xsrc + (size_t)m * D + 4 * lane + 256 * jj);
        if (WHICH == 0 && l == 1 && m >= CH_TOK) {
            const bf16* slots = (const bf16*)(a.wsp() + WS_SLOT); const float* g2 = mod + (size_t)(0 * 8 + b) * 6144 + 5120;
#pragma unroll
            for (int jj = 0; jj < 4; ++jj) { const int c = 4 * lane + 256 * jj; f32x4 s = (f32x4){0.f, 0.f, 0.f, 0.f};
#pragma unroll
                for (int k = 0; k < NSLOT; ++k) { const v2u w = *(const v2u*)(slots + ((size_t)(m - CH_TOK) * NSLOT + k) * 1024 + c); s.x += bflo(w.x); s.y += bfhi(w.x); s.z += bflo(w.y); s.w += bfhi(w.y); }
                v[jj] = v[jj] + *(const f32x4*)(g2 + c) * s; *(f32x4*)(a.outp() + (size_t)m * D + c) = v[jj]; }
        }
        float ss = 0.f;
#pragma unroll
        for (int jj = 0; jj < 4; ++jj) ss += (v[jj].x * v[jj].x + v[jj].y * v[jj].y) + (v[jj].z * v[jj].z + v[jj].w * v[jj].w);
        const float rstd = 1.0f / sqrtf(wave_sum(ss) * (1.0f / D) + EPS);
        f32x4 hv[4];
#pragma unroll
        for (int jj = 0; jj < 4; ++jj) { const int c = 4 * lane + 256 * jj; hv[jj] = v[jj] * rstd * gA[jj] + gB[jj];
            v2u o; o.x = pk2(hv[jj].x, hv[jj].y); o.y = pk2(hv[jj].z, hv[jj].w); *(v2u*)(H + (size_t)m * D + c) = o; }
        if (WHICH == 0) {
#pragma unroll
            for (int j = 0; j < 8; ++j) { float fj = 0.f;
#pragma unroll
                for (int jj = 0; jj < 4; ++jj) { const f32x4 w = *(const LAS f32x4*)(wfl + j * 1024 + 4 * lane + 256 * jj); fj += (hv[jj].x * w.x + hv[jj].y * w.y) + (hv[jj].z * w.z + hv[jj].w * w.w); }
                const float f = wave_sum(fj) + a.in[I_BF][l * 8 + j];
                const float ls = fminf(f, 0.f) - log1pf(__expf(-fabsf(f)));
                if (lane == 0) ((float*)(a.wsp() + WS_LOGF))[(size_t)(b * 8 + j) * SEQ + (m & (SEQ - 1))] = ls;
                asm volatile("" ::: "memory"); } }
    }
}

__device__ __forceinline__ void route_block(const ArgsV& a, int l, int blk, LAS unsigned char* lds, int tid) {
    LAS int* cntl = (LAS int*)lds;
    if (tid < 64) cntl[tid] = 0;
    __syncthreads();
    if (tid < 128) {
        const int tok = blk * 128 + tid;
        const float* lg = (const float*)(a.wsp() + WS_LOGIT) + (size_t)tok * 64;
        const float* rb = a.in[I_RB] + l * 64;
        float sc[64], bs[64];
#pragma unroll
        for (int q = 0; q < 16; ++q) { const f32x4 v = *(const f32x4*)(lg + 4 * q); const f32x4 bb = *(const f32x4*)(rb + 4 * q);
            sc[4 * q + 0] = sigmoidf_(v.x); sc[4 * q + 1] = sigmoidf_(v.y); sc[4 * q + 2] = sigmoidf_(v.z); sc[4 * q + 3] = sigmoidf_(v.w);
            bs[4 * q + 0] = sc[4 * q + 0] + bb.x; bs[4 * q + 1] = sc[4 * q + 1] + bb.y; bs[4 * q + 2] = sc[4 * q + 2] + bb.z; bs[4 * q + 3] = sc[4 * q + 3] + bb.w; }
        float gs[8];
#pragma unroll
        for (int g = 0; g < 8; ++g) { float m1 = -INFINITY, m2 = -INFINITY;
#pragma unroll
            for (int j = 0; j < 8; ++j) { const float v = bs[8 * g + j]; if (v > m1) { m2 = m1; m1 = v; } else if (v > m2) { m2 = v; } }
            gs[g] = m1 + m2; }
        unsigned gmask = 0u;
#pragma unroll
        for (int p = 0; p < 4; ++p) { float best = -INFINITY; int bi = 0;
#pragma unroll
            for (int g = 0; g < 8; ++g) { const bool ok = !((gmask >> g) & 1u) && gs[g] > best; best = ok ? gs[g] : best; bi = ok ? g : bi; }
            gmask |= 1u << bi; }
#pragma unroll
        for (int e = 0; e < 64; ++e) bs[e] = ((gmask >> (e >> 3)) & 1u) ? bs[e] : -INFINITY;
        int idx[8]; float wv[8]; float wsum = 0.f;
#pragma unroll
        for (int p = 0; p < 8; ++p) { float best = -INFINITY; int bi = 0; float bsc = 0.f;
#pragma unroll
            for (int e = 0; e < 64; ++e) { const bool ok = bs[e] > best; best = ok ? bs[e] : best; bi = ok ? e : bi; bsc = ok ? sc[e] : bsc; }
#pragma unroll
            for (int e = 0; e < 64; ++e) bs[e] = (e == bi) ? -INFINITY : bs[e];
            idx[p] = bi; wv[p] = bsc; wsum += bsc; }
        const float scale = 2.5f / wsum;
        int* ridx = (int*)(a.wsp() + WS_RIDX) + (size_t)tok * 8; float* rw = (float*)(a.wsp() + WS_RW) + (size_t)tok * 8;
#pragma unroll
        for (int p = 0; p < 8; ++p) { ridx[p] = idx[p]; rw[p] = wv[p] * scale; __hip_atomic_fetch_add(&cntl[idx[p]], 1, __ATOMIC_RELAXED, __HIP_MEMORY_SCOPE_WORKGROUP); }
    }
    __syncthreads();
    if (tid < 64) ((int*)(a.wsp() + WS_CNT))[blk * 64 + tid] = cntl[tid];
    __syncthreads();
}

__device__ __forceinline__ void build_lists(const ArgsV& a, int blk, LAS unsigned char* lds, int tid) {
    LAS int* idxl = (LAS int*)lds;
    LAS float* wl = (LAS float*)(lds + 4096);
    LAS int* totl = (LAS int*)(lds + 8192);
    LAS int* prel = (LAS int*)(lds + 8192 + 256);
    LAS int* pstl = (LAS int*)(lds + 8192 + 512);
    const int ch = blk >> 7, jb = blk & 127, tok0 = blk * 128;
    const int* cnt = (const int*)(a.wsp() + WS_CNT);
    for (int i = tid; i < 1024; i += 512) { idxl[i] = ((const int*)(a.wsp() + WS_RIDX))[(size_t)tok0 * 8 + i]; wl[i] = ((const float*)(a.wsp() + WS_RW))[(size_t)tok0 * 8 + i]; }
    if (tid < 64) { int tot = 0, pre = 0;
        for (int j = 0; j < 128; ++j) { const int c = cnt[(ch * 128 + j) * 64 + tid]; tot += c; pre += (j < jb) ? c : 0; }
        totl[tid] = tot; prel[tid] = pre; }
    __syncthreads();
    if (tid == 0) { int run = 0; for (int e = 0; e < 64; ++e) { pstl[e] = run; run += (totl[e] + 255) & ~255; } pstl[64] = run; }
    __syncthreads();
    int* rtok = (int*)(a.wsp() + WS_RTOK) + (size_t)ch * RMAX; float* rwt = (float*)(a.wsp() + WS_RWT) + (size_t)ch * RMAX; int* rdst = (int*)(a.wsp() + WS_RDST) + (size_t)ch * RMAX;
    if (tid < 64) { int pos = pstl[tid] + prel[tid];
        for (int i = 0; i < 1024; ++i) if (idxl[i] == tid) { const int tok = tok0 + (i >> 3); rtok[pos] = tok; rwt[pos] = wl[i]; rdst[pos] = (tok - ch * CH_TOK) * NSLOT + (i & 7); ++pos; } }
    if (tid >= 128 && tid < 256) { const int tok = tok0 + (tid - 128); const int r = pstl[64] + (tok - ch * CH_TOK); rtok[r] = tok; rwt[r] = 1.0f; rdst[r] = (tok - ch * CH_TOK) * NSLOT + 8; }
    if (jb < 64) { const int e = jb, p0 = pstl[e] + totl[e], p1 = pstl[e] + ((totl[e] + 255) & ~255);
        for (int r = p0 + tid; r < p1; r += 512) { rtok[r] = T; rwt[r] = 0.f; rdst[r] = -1; } }
    if (jb == 64) { int* meta = (int*)(a.wsp() + WS_META) + ch * 128; int* tile_e = (int*)(a.wsp() + WS_META) + 1024 + ch * 1024;
        const int nt_all = (pstl[64] + CH_TOK) >> 8;
        if (tid == 0) meta[0] = nt_all;
        for (int t = tid; t < nt_all; t += 512) { const int r = t << 8; int e = 64;
            for (int q = 0; q < 64; ++q) if (r >= pstl[q] && r < pstl[q + 1]) e = q;
            tile_e[t] = e; } }
    __syncthreads();
}

struct SchedDense { static constexpr bool EARLY_VOFF = false; pg8::TileOrder o; unsigned rowbytes;
    __device__ __forceinline__ bool next(int i, pg8::Unit& u) const { int pm, pn; if (!o.get(i, pm, pn)) return false; u.pm = pm; u.pn = pn; u.bt = pn; u.aux = 0; return true; }
    __device__ __forceinline__ unsigned a_off(const pg8::Unit& u, int r) const { return (unsigned)(u.pm * 256 + r) * rowbytes; } };
struct SchedProj { static constexpr bool EARLY_VOFF = false; pg8::TileOrder o; unsigned rowbytes, delta;
    __device__ __forceinline__ bool next(int i, pg8::Unit& u) const { int pm, pn; if (!o.get(i >> 1, pm, pn)) return false; u.pm = pm; u.pn = pn; u.aux = i & 1; u.bt = (i & 1) * 4 + pn; return true; }
    __device__ __forceinline__ unsigned a_off(const pg8::Unit& u, int r) const { return (unsigned)u.aux * delta + (unsigned)(u.pm * 256 + r) * rowbytes; } };
template <bool GATHER> struct SchedMoe { static constexpr bool EARLY_VOFF = GATHER; const int* tile_e; const int* row_tok; int nunits, G, c, npn_log2; unsigned rowbytes;
    __device__ __forceinline__ bool next(int i, pg8::Unit& u) const { const int L = i * G + c; if (L >= nunits) return false; const int rt = L >> npn_log2, pn = L & ((1 << npn_log2) - 1); const int e = tile_e[rt];
        u.pm = rt; u.pn = pn; u.bt = (e << npn_log2) + pn; u.aux = e; return true; }
    __device__ __forceinline__ unsigned a_off(const pg8::Unit& u, int r) const { const int row = GATHER ? row_tok[u.pm * 256 + r] : (u.pm * 256 + r); return (unsigned)row * rowbytes; } };

struct EpiIn { static constexpr bool PERM = true;
    bf16* qkv; bf16* gates; const float* gains;
    __device__ __forceinline__ void operator()(const pg8::f32x4 (&acc)[2][2][4][2], const pg8::Unit& u, int wr, int wc, int fr, int fq) const {
        const int pn = u.pn, row0 = u.pm * 256 + wr * 64 + fr;
        if (pn < 12) {
            const int buf = pn >> 1, kind = buf % 3;
            bf16* out = qkv + (size_t)buf * QKV_STRIDE; const int colbase = 256 * (pn & 1) + 64 * wc + 8 * fq;
            const float* gp = gains + ((buf < 3 ? 0 : 2) + (kind & 1)) * 64;
            f32x4 gv[2][2];
#pragma unroll
            for (int bj = 0; bj < 2; ++bj)
#pragma unroll
                for (int n = 0; n < 2; ++n) gv[bj][n] = (kind < 2) ? *(const f32x4*)(gp + 32 * bj + 8 * fq + 4 * n) : (f32x4){1.f, 1.f, 1.f, 1.f};
#pragma unroll
            for (int ai = 0; ai < 2; ++ai)
#pragma unroll
                for (int m = 0; m < 4; ++m) { const int row = row0 + ai * 128 + m * 16; float rs = 1.0f;
                    if (kind < 2) { float ss = 0.f;
#pragma unroll
                        for (int bj = 0; bj < 2; ++bj)
#pragma unroll
                            for (int n = 0; n < 2; ++n) { const f32x4 x = acc[ai][bj][m][n]; ss += (x.x * x.x + x.y * x.y) + (x.z * x.z + x.w * x.w); }
                        ss += __shfl_xor(ss, 16); ss += __shfl_xor(ss, 32);
                        rs = 1.0f / sqrtf(ss * (1.0f / 64.0f) + EPS); if (kind == 0) rs *= C2; }
#pragma unroll
                    for (int bj = 0; bj < 2; ++bj) { const f32x4 v0 = acc[ai][bj][m][0] * rs * gv[bj][0], v1 = acc[ai][bj][m][1] * rs * gv[bj][1];
                        v4u w; w.x = pg8::cvt_pk_bf16(v0.x, v0.y); w.y = pg8::cvt_pk_bf16(v0.z, v0.w); w.z = pg8::cvt_pk_bf16(v1.x, v1.y); w.w = pg8::cvt_pk_bf16(v1.z, v1.w);
                        *(v4u*)(out + (size_t)row * 512 + colbase + 32 * bj) = w; } }
        } else {
            bf16* out = gates + (size_t)((pn - 12) >> 2) * G_STRIDE; const int colbase = 256 * ((pn - 12) & 3) + 64 * wc + 8 * fq;
#pragma unroll
            for (int ai = 0; ai < 2; ++ai)
#pragma unroll
                for (int m = 0; m < 4; ++m) { const int row = row0 + ai * 128 + m * 16;
#pragma unroll
                    for (int bj = 0; bj < 2; ++bj) { const f32x4 a0 = acc[ai][bj][m][0], a1 = acc[ai][bj][m][1];
                        v4u w; w.x = pg8::cvt_pk_bf16(sigmoidf_(a0.x), sigmoidf_(a0.y)); w.y = pg8::cvt_pk_bf16(sigmoidf_(a0.z), sigmoidf_(a0.w));
                        w.z = pg8::cvt_pk_bf16(sigmoidf_(a1.x), sigmoidf_(a1.y)); w.w = pg8::cvt_pk_bf16(sigmoidf_(a1.z), sigmoidf_(a1.w));
                        *(v4u*)(out + (size_t)row * 1024 + colbase + 32 * bj) = w; } }
        }
    } };
struct EpiProj { static constexpr bool PERM = true;
    const bf16* gates; bf16* M;
    __device__ __forceinline__ void operator()(const pg8::f32x4 (&acc)[2][2][4][2], const pg8::Unit& u, int wr, int wc, int fr, int fq) const {
        const int pass = u.aux; const bf16* g = gates + (size_t)pass * G_STRIDE; const int col0 = u.pn * 256 + wc * 32 + 8 * fq;
#pragma unroll
        for (int ai = 0; ai < 2; ++ai)
#pragma unroll
            for (int m = 0; m < 4; ++m) { const size_t rowoff = (size_t)(u.pm * 256 + ai * 128 + wr * 64 + m * 16 + fr) * 1024;
#pragma unroll
                for (int bj = 0; bj < 2; ++bj) { const size_t off = rowoff + col0 + bj * 128; const v4u gw_ = *(const v4u*)(g + off);
                    const f32x4 a0 = acc[ai][bj][m][0], a1 = acc[ai][bj][m][1];
                    float r0 = bflo(gw_.x) * a0.x, r1 = bfhi(gw_.x) * a0.y, r2 = bflo(gw_.y) * a0.z, r3 = bfhi(gw_.y) * a0.w, r4 = bflo(gw_.z) * a1.x, r5 = bfhi(gw_.z) * a1.y, r6 = bflo(gw_.w) * a1.z, r7 = bfhi(gw_.w) * a1.w;
                    if (pass) { const v4u p = *(const v4u*)(M + off); r0 += bflo(p.x); r1 += bfhi(p.x); r2 += bflo(p.y); r3 += bfhi(p.y); r4 += bflo(p.z); r5 += bfhi(p.z); r6 += bflo(p.w); r7 += bfhi(p.w); }
                    v4u w; w.x = pg8::cvt_pk_bf16(r0, r1); w.y = pg8::cvt_pk_bf16(r2, r3); w.z = pg8::cvt_pk_bf16(r4, r5); w.w = pg8::cvt_pk_bf16(r6, r7);
                    *(v4u*)(M + off) = w; } }
    } };
struct EpiOut { static constexpr bool PERM = false;
    const float* xin; float* xout; const float* g1;
    __device__ __forceinline__ void operator()(const pg8::f32x4 (&acc)[2][2][4][2], const pg8::Unit& u, int wr, int wc, int fr, int fq) const {
        const int b = (u.pm * 256) >> 12, col0 = u.pn * 256 + wc * 32 + 4 * fq;
#pragma unroll
        for (int bj = 0; bj < 2; ++bj)
#pragma unroll
            for (int n = 0; n < 2; ++n) { const f32x4 gv = *(const f32x4*)(g1 + (size_t)b * 6144 + col0 + bj * 128 + n * 16);
#pragma unroll
                for (int ai = 0; ai < 2; ++ai)
#pragma unroll
                    for (int m = 0; m < 4; ++m) { const size_t off = (size_t)(u.pm * 256 + ai * 128 + wr * 64 + m * 16 + fr) * 1024 + col0 + bj * 128 + n * 16;
                        const f32x4 xv = *(const f32x4*)(xin + off); *(f32x4*)(xout + off) = xv + gv * acc[ai][bj][m][n]; } }
    } };
struct EpiRouter { static constexpr bool PERM = false;
    float* logits;
    __device__ __forceinline__ void operator()(const pg8::f32x4 (&acc)[2][2][4][2], const pg8::Unit& u, int wr, int wc, int fr, int fq) const {
        if (wc < 2) {
#pragma unroll
            for (int ai = 0; ai < 2; ++ai)
#pragma unroll
                for (int m = 0; m < 4; ++m)
#pragma unroll
                    for (int n = 0; n < 2; ++n) *(f32x4*)(logits + (size_t)(u.pm * 256 + ai * 128 + wr * 64 + m * 16 + fr) * 64 + wc * 32 + n * 16 + 4 * fq) = acc[ai][0][m][n]; }
    } };
struct EpiGU { static constexpr bool PERM = true;
    bf16* act;
    __device__ __forceinline__ void operator()(const pg8::f32x4 (&acc)[2][2][4][2], const pg8::Unit& u, int wr, int wc, int fr, int fq) const {
        const int col0 = u.pn * 128 + wc * 32 + 8 * fq;
#pragma unroll
        for (int ai = 0; ai < 2; ++ai)
#pragma unroll
            for (int m = 0; m < 4; ++m) { const size_t row = (size_t)(u.pm * 256 + ai * 128 + wr * 64 + m * 16 + fr);
                const f32x4 g0 = acc[ai][0][m][0], g1 = acc[ai][0][m][1], u0 = acc[ai][1][m][0], u1 = acc[ai][1][m][1];
                v4u w; w.x = pg8::cvt_pk_bf16(g0.x * sigmoidf_(g0.x) * u0.x, g0.y * sigmoidf_(g0.y) * u0.y); w.y = pg8::cvt_pk_bf16(g0.z * sigmoidf_(g0.z) * u0.z, g0.w * sigmoidf_(g0.w) * u0.w);
                w.z = pg8::cvt_pk_bf16(g1.x * sigmoidf_(g1.x) * u1.x, g1.y * sigmoidf_(g1.y) * u1.y); w.w = pg8::cvt_pk_bf16(g1.z * sigmoidf_(g1.z) * u1.z, g1.w * sigmoidf_(g1.w) * u1.w);
                *(v4u*)(act + row * 256 + col0) = w; }
    } };
struct EpiDown { static constexpr bool PERM = true;
    bf16* slots; const float* row_w; const int* row_dst;
    __device__ __forceinline__ void operator()(const pg8::f32x4 (&acc)[2][2][4][2], const pg8::Unit& u, int wr, int wc, int fr, int fq) const {
        const int col0 = u.pn * 256 + wc * 32 + 8 * fq;
#pragma unroll
        for (int ai = 0; ai < 2; ++ai)
#pragma unroll
            for (int m = 0; m < 4; ++m) { const int grow = u.pm * 256 + ai * 128 + wr * 64 + m * 16 + fr; const float w = row_w[grow]; const int dst = row_dst[grow];
                if (dst >= 0) {
#pragma unroll
                    for (int bj = 0; bj < 2; ++bj) { const f32x4 a0 = acc[ai][bj][m][0] * w, a1 = acc[ai][bj][m][1] * w;
                        v4u o; o.x = pg8::cvt_pk_bf16(a0.x, a0.y); o.y = pg8::cvt_pk_bf16(a0.z, a0.w); o.z = pg8::cvt_pk_bf16(a1.x, a1.y); o.w = pg8::cvt_pk_bf16(a1.z, a1.w);
                        *(v4u*)(slots + (size_t)dst * 1024 + col0 + bj * 128) = o; } } }
    } };
#ifndef PH_MASK
#define PH_MASK 0xffffffffu
#endif
#define PH(k) ((PH_MASK >> (k)) & 1u)
__global__ void __launch_bounds__(NWAVES * 64, 2) mk_fwd(Args args_unused) {
    const ArgsV args{};
    extern __shared__ __attribute__((aligned(16))) unsigned char lds_raw[];
    LAS unsigned char* lds = (LAS unsigned char*)lds_raw;
    volatile LAS unsigned* MISC = (volatile LAS unsigned*)(lds + MISC_OFF);
    const int G = gridDim.x, bx = blockIdx.x;
    const int vcu = (G % 8 == 0) ? (bx % 8) * (G / 8) + bx / 8 : bx;
    for (int u = threadIdx.x; u < (LDS_BYTES - LDSCTL_OFF) / 4; u += NWAVES * 64) ((LAS unsigned*)(lds + LDSCTL_OFF))[u] = 0u;
    __syncthreads();
    XcdBarrier bar = xcd_barrier_post((unsigned*)(args.wsp() + WS_CTL) + CW_BAR, MISC + 8);
    const int NGW = G * NWAVES;
#define PHASE_IDS int tid = threadIdx.x; asm volatile("" : "+v"(tid)); const int lane = tid & 63; const int wave = __builtin_amdgcn_readfirstlane(tid >> 6); const int gw = vcu * NWAVES + wave; (void)lane; (void)gw;
#define Hb ((bf16*)(args.wsp() + WS_H))
#define QKVb ((bf16*)(args.wsp() + WS_QKV))
#define Gb ((bf16*)(args.wsp() + WS_G))
#define MODb ((float*)(args.wsp() + WS_MOD))

    { PHASE_IDS
    if (PH(0)) { for (int u = bx; u < 192; u += G) mod_unit(args, u, lds, tid, wave, lane); }
    if (PH(1)) convert_weights(args, 0, lds, gw, NGW, wave, lane); }
    xcd_barrier(bar);

    for (int l = 0; l < DEPTH; ++l) {
        { PHASE_IDS
        if (PH(1) && l == 1) convert_weights(args, 1, lds, gw, NGW, wave, lane);
        if (PH(2)) { LAS float* wfl = (LAS float*)(lds + 73728); const float* wsrc = args.in[I_WIN] + (size_t)l * D * NIN + 3072;
          for (int k = tid; k < 1024; k += 512) { const f32x4 w0 = *(const f32x4*)(wsrc + (size_t)k * NIN), w1 = *(const f32x4*)(wsrc + (size_t)k * NIN + 4);
              wfl[0 * 1024 + k] = w0.x; wfl[1 * 1024 + k] = w0.y; wfl[2 * 1024 + k] = w0.z; wfl[3 * 1024 + k] = w0.w; wfl[4 * 1024 + k] = w1.x; wfl[5 * 1024 + k] = w1.y; wfl[6 * 1024 + k] = w1.z; wfl[7 * 1024 + k] = w1.w; }
          if (bx == 0 && wave < 4) ((float*)(args.wsp() + WS_GAIN))[wave * 64 + lane] = args.in[I_QNA + wave][l * 64 + lane];
          __syncthreads();
          for (int g = gw; g < T / 16; g += NGW) norm_rows<0>(args, l, lds, g, lane);
          __syncthreads(); } }
        xcd_barrier(bar);

        if (PH(3)) for (int s = bx; s < 64; s += G) { PHASE_IDS
            const float* lf = (const float*)(args.wsp() + WS_LOGF) + (size_t)s * SEQ; float* cm = (float*)(args.wsp() + WS_CUM) + (size_t)s * SEQ;
            LAS float* wtot = (LAS float*)lds;
            const f32x4 a0 = *(const f32x4*)(lf + 8 * tid), a1 = *(const f32x4*)(lf + 8 * tid + 4);
            float v[8]; v[0] = a0.x; v[1] = v[0] + a0.y; v[2] = v[1] + a0.z; v[3] = v[2] + a0.w; v[4] = v[3] + a1.x; v[5] = v[4] + a1.y; v[6] = v[5] + a1.z; v[7] = v[6] + a1.w;
            float inc = v[7];
#pragma unroll
            for (int o = 1; o < 64; o <<= 1) { const float t = __shfl_up(inc, o); if (lane >= o) inc += t; }
            if (lane == 63) wtot[wave] = inc;
            __syncthreads();
            float base = inc - v[7];
            for (int w = 0; w < wave; ++w) base += wtot[w];
            *(f32x4*)(cm + 8 * tid) = (f32x4){v[0] + base, v[1] + base, v[2] + base, v[3] + base};
            *(f32x4*)(cm + 8 * tid + 4) = (f32x4){v[4] + base, v[5] + base, v[6] + base, v[7] + base};
            __syncthreads();
        }
        if (PH(4)) { SchedDense S; S.o.init(T / 256, 20, G, bx); S.rowbytes = 2048;
          EpiIn E{QKVb, Gb, (const float*)(args.wsp() + WS_GAIN)};
          pg8::gemm_phase<EpiIn, SchedDense>(lds, Hb, (const bf16*)(args.wsp() + WS_WIN), 1024, S, E); }
        xcd_barrier(bar);

        if (PH(5)) for (int v = vcu; v < 256; v += G) {
            const int bh = v >> 2, s = v & 3, b = bh >> 3, h = bh & 7;
            const float* cum = (const float*)(args.wsp() + WS_CUM); const float* rel = args.in[I_REL] + (size_t)l * 8 * 257;
            for (int i = 0; i < 4; ++i) { const int qb = (i == 0) ? s : (i == 1) ? 7 - s : (i == 2) ? 8 + s : 15 - s;
                att::attn_unit<0>(b, h, qb, QKVb + 3 * QKV_STRIDE, QKVb + 4 * QKV_STRIDE, QKVb + 5 * QKV_STRIDE, QKVb + 3 * QKV_STRIDE, cum, rel, lds); }
            for (int i = 0; i < 4; ++i) att::attn_unit<1>(b, h, 4 * s + i, QKVb, QKVb + 1 * QKV_STRIDE, QKVb + 2 * QKV_STRIDE, QKVb, cum, rel, lds);
        }
        __syncthreads();
        xcd_barrier(bar);

        if (PH(6)) { SchedProj S; S.o.init(T / 256, 4, G, bx); S.rowbytes = 1024; S.delta = (unsigned)(3 * QKV_STRIDE * 2);
          EpiProj E{Gb, Hb};
          pg8::gemm_phase<EpiProj, SchedProj>(lds, QKVb, (const bf16*)(args.wsp() + WS_WPROJ), 512, S, E); }
        xcd_barrier(bar);

        if (PH(7)) { SchedDense S; S.o.init(T / 256, 4, G, bx); S.rowbytes = 2048;
          EpiOut E{l == 0 ? args.in[I_X] : args.outp(), args.outp(), MODb + (size_t)l * 8 * 6144 + 2048};
          pg8::gemm_phase<EpiOut, SchedDense>(lds, Hb, (const bf16*)(args.wsp() + WS_WOUT), 1024, S, E); }
        xcd_barrier(bar);

        { PHASE_IDS
        if (PH(8)) for (int g = gw; g < T / 16; g += NGW) norm_rows<1>(args, l, lds, g, lane);
        if (bx == 0) ((unsigned*)(Hb + (size_t)T * D))[tid] = 0u; }
        xcd_barrier(bar);

        if (PH(9)) { SchedDense S; S.o.init(T / 256, 1, G, bx); S.rowbytes = 2048;
          EpiRouter E{(float*)(args.wsp() + WS_LOGIT)};
          pg8::gemm_phase<EpiRouter, SchedDense>(lds, Hb, (const bf16*)(args.wsp() + WS_WR), 1024, S, E); }
        xcd_barrier(bar);

        if (PH(10)) for (int blk = bx; blk < 256; blk += G) { PHASE_IDS route_block(args, l, blk, lds, tid); }
        xcd_barrier(bar);
        if (PH(11)) for (int blk = bx; blk < 256; blk += G) { PHASE_IDS build_lists(args, blk, lds, tid); }
        xcd_barrier(bar);

        for (int c = 0; c < NCHUNK; ++c) {
            if (PH(12) && c == 1) { PHASE_IDS reduce_rows(args, l, 0, CH_TOK, 0, gw, NGW, lane); }
            const int ntl = ((const int*)(args.wsp() + WS_META))[c * 128];
            const int* tile_e = (const int*)(args.wsp() + WS_META) + 1024 + c * 1024;
            if (PH(13)) { SchedMoe<true> S{tile_e, (const int*)(args.wsp() + WS_RTOK) + (size_t)c * RMAX, ntl * 2, G, vcu, 1, 2048u};
              EpiGU E{(bf16*)(args.wsp() + WS_ACT)};
              pg8::gemm_phase<EpiGU, SchedMoe<true>>(lds, Hb, (const bf16*)(args.wsp() + WS_WGU), 1024, S, E); }
            xcd_barrier(bar);
            if (PH(14)) { SchedMoe<false> S{tile_e, nullptr, ntl * 4, G, vcu, 2, 512u};
              EpiDown E{(bf16*)(args.wsp() + WS_SLOT), (const float*)(args.wsp() + WS_RWT) + (size_t)c * RMAX, (const int*)(args.wsp() + WS_RDST) + (size_t)c * RMAX};
              pg8::gemm_phase<EpiDown, SchedMoe<false>>(lds, (const bf16*)(args.wsp() + WS_ACT), (const bf16*)(args.wsp() + WS_WD), 256, S, E); }
            xcd_barrier(bar);
        }
    }
    if (PH(12)) { PHASE_IDS reduce_rows(args, DEPTH - 1, CH_TOK, T, CH_TOK, gw, NGW, lane); }
}

#undef Hb
#undef QKVb
#undef Gb
#undef MODb
extern "C" void kernel_launch(void* const* d_in, const int* in_sizes, int n_in, void* d_out, int out_size, void* d_ws, size_t ws_size, hipStream_t stream) {
    static int grid = 0;
    if (grid == 0) {
        if (n_in != 24 || out_size != T * D || ws_size < WS_END) { fprintf(stderr, "kernel_launch: unexpected shapes (n_in %d, out %d, ws %zu)\n", n_in, out_size, ws_size); grid = -1; return; }
        int dev = 0, cus = 0, per_cu = 0;
        if (hipGetDevice(&dev) != hipSuccess || hipDeviceGetAttribute(&cus, hipDeviceAttributeMultiprocessorCount, dev) != hipSuccess) { grid = -1; return; }
        if (hipFuncSetAttribute((const void*)mk_fwd, hipFuncAttributeMaxDynamicSharedMemorySize, LDS_BYTES) != hipSuccess) { fprintf(stderr, "kernel_launch: hipFuncSetAttribute failed\n"); grid = -1; return; }
        if (hipOccupancyMaxActiveBlocksPerMultiprocessor(&per_cu, (const void*)mk_fwd, NWAVES * 64, LDS_BYTES) != hipSuccess || per_cu < 1) fprintf(stderr, "kernel_launch: occupancy query reports %d\n", per_cu);
        (void)hipGetLastError();
        grid = cus;
    }
    if (grid < 0) return;
    if (hipMemsetAsync((char*)d_ws + WS_CTL, 0, CTL_ZERO_BYTES, stream) != hipSuccess) return;
    Args a{};
    for (int i = 0; i < 24; ++i) a.in[i] = (const float*)d_in[i];
    a.out = (float*)d_out; a.ws = (unsigned char*)d_ws;
    hipLaunchKernelGGL(mk_fwd, dim3(grid), dim3(NWAVES * 64), LDS_BYTES, stream, a);
}
```

```cpp
#include <hip/hip_runtime.h>
#include <hip/hip_bf16.h>
#include <cstdio>
#include <cstdint>
#include <cmath>
namespace pg8 {
#define PG8_LAS __attribute__((address_space(3)))
typedef unsigned short bf16_t;
typedef short bf16x8 __attribute__((ext_vector_type(8)));
typedef float f32x4 __attribute__((ext_vector_type(4)));
typedef float f32x2 __attribute__((ext_vector_type(2)));
typedef unsigned u32x4 __attribute__((ext_vector_type(4)));
constexpr int BM = 256, BK = 64, HALF = 128, HTB = HALF * BK * 2  , STAGE_BYTES = 8 * HTB, NXCD = 8, WGM = 8;

__host__ __device__ __forceinline__ int lds_byte(int r, int c) { const int st = (r >> 4) * 2 + (c >> 5), rr = r & 15, cc = c & 31, ob = rr * 64 + cc * 2; return st * 1024 + (ob ^ (((ob >> 9) & 1) << 5)); }
__host__ __device__ __forceinline__ void stage_rc(int b, int& R, int& C) { const int st = b / 1024, sb = b % 1024, swz = sb ^ (((sb >> 9) & 1) << 5); R = (st >> 1) * 16 + swz / 64; C = (st & 1) * 32 + (swz % 64) / 2; }
__host__ __device__ __forceinline__ int perm32(int rho) { const int n = rho >> 4, i = rho & 15; return 8 * (i >> 2) + 4 * n + (i & 3); }

struct Unit { int pm, pn, bt, aux; };

struct TileOrder {
    int nM, nN, nwg, G, c;
    __device__ __forceinline__ void init(int nM_, int nN_, int G_, int c_) { nM = nM_; nN = nN_; nwg = nM * nN; G = G_; c = c_; }
    template <int NM, int NN> __device__ __forceinline__ bool get_c(int i, int& pm, int& pn) const {
        constexpr int NWG = NM * NN; const int L = i * G + c; if (L >= NWG) return false;
        int wgid = L; { constexpr int q = NWG / NXCD, r = NWG % NXCD; const int xcd = wgid % NXCD, off = wgid / NXCD; wgid = (xcd < r ? xcd * (q + 1) : r * (q + 1) + (xcd - r) * q) + off; }
        constexpr int nig = WGM * NN; static_assert(NM % WGM == 0, "full row groups"); const int gid = wgid / nig, fm = gid * WGM;
        pm = fm + ((wgid % nig) % WGM); pn = (wgid % nig) / WGM; return true;
    }
    __device__ __forceinline__ bool get(int i, int& pm, int& pn) const {
        if (nM == 128 && nN == 20) return get_c<128, 20>(i, pm, pn);
        if (nM == 128 && nN == 4) return get_c<128, 4>(i, pm, pn);
        const long L = (long)i * G + c; if (L >= nwg) return false;
        int wgid = (int)L; { const int q = nwg / NXCD, r = nwg % NXCD, xcd = wgid % NXCD, off = wgid / NXCD; wgid = (xcd < r ? xcd * (q + 1) : r * (q + 1) + (xcd - r) * q) + off; }
        const int nig = WGM * nN, gid = wgid / nig, fm = gid * WGM, gsz = (nM - fm) < WGM ? (nM - fm) : WGM;
        pm = fm + ((wgid % nig) % gsz); pn = (wgid % nig) / gsz; return true;
    }
};

__device__ __forceinline__ unsigned cvt_pk_bf16(float lo, float hi) { unsigned r; asm volatile("v_cvt_pk_bf16_f32 %0, %1, %2" : "=v"(r) : "v"(lo), "v"(hi)); return r; }
__device__ __forceinline__ float bf_lo(unsigned w) { return __uint_as_float(w << 16); }
__device__ __forceinline__ float bf_hi(unsigned w) { return __uint_as_float(w & 0xffff0000u); }

template <class Epi, class Sched, bool FP8 = false>
__device__ __forceinline__ void gemm_phase(PG8_LAS unsigned char* lds, const void* Abase, const bf16_t* Bt, const int K, const Sched& S, const Epi& E, const int KBp = 0) {
    const int KB = KBp ? KBp : K;
    int tid_ = threadIdx.x; asm volatile("" : "+v"(tid_));
    const int tid = tid_, wid = __builtin_amdgcn_readfirstlane(tid >> 6), lane = tid & 63, wr = wid >> 2, wc = wid & 3, fr = lane & 15, fq = lane >> 4;
    const int nt = K / BK;
    unsigned voffB[2];
#pragma unroll
    for (int i = 0; i < 2; ++i) { int R, C; stage_rc(tid * 16 + i * 8192, R, C); const int Rb = Epi::PERM ? ((R & ~31) + perm32(R & 31)) : R;
        voffB[i] = (unsigned)(Rb * KB + C) * 2u; }
    const size_t kstep = (size_t)(BK * 2);
    const size_t hstep = (size_t)HALF * KB * 2;
    const size_t tstep = 2 * hstep;
    const unsigned ldsw = (unsigned)wid * 1024u;
    const int aoff = lds_byte(wr * 64 + fr, fq * 8), boff = lds_byte(wc * 32 + fr, fq * 8);
#define PG8_SA(b, h) (((b) * 2 + (h)) * HTB)
#define PG8_SB(b, h) ((4 + (b) * 2 + (h)) * HTB)
#define PG8_STAGE(bufoff, gbase, voff) do { _Pragma("unroll") for (int _i = 0; _i < 2; ++_i) \
        __builtin_amdgcn_global_load_lds((const unsigned*)((const char*)(gbase) + (voff)[_i]), (PG8_LAS unsigned*)(lds + (bufoff) + ldsw + _i * 8192), 16, 0, 0); } while (0)
#define PG8_LDA(dst, b, h) do { _Pragma("unroll") for (int m = 0; m < 4; ++m) _Pragma("unroll") for (int k = 0; k < 2; ++k) dst[m][k] = *(const PG8_LAS bf16x8*)(lds + PG8_SA(b, h) + aoff + m * 2048 + k * 1024); } while (0)
#define PG8_LDB(dst, b, h) do { _Pragma("unroll") for (int n = 0; n < 2; ++n) _Pragma("unroll") for (int k = 0; k < 2; ++k) dst[n][k] = *(const PG8_LAS bf16x8*)(lds + PG8_SB(b, h) + boff + n * 2048 + k * 1024); } while (0)
typedef int v4i_t __attribute__((ext_vector_type(4))); typedef int v8i_t __attribute__((ext_vector_type(8)));
#define PG8_MMA(ai, bj, At, Bt_) do { __builtin_amdgcn_s_setprio(1); _Pragma("unroll") for (int m = 0; m < 4; ++m) _Pragma("unroll") for (int n = 0; n < 2; ++n) { \
        if constexpr (FP8) { const v8i_t a_ = __builtin_shufflevector(__builtin_bit_cast(v4i_t, At[m][0]), __builtin_bit_cast(v4i_t, At[m][1]), 0, 1, 2, 3, 4, 5, 6, 7); \
            const v8i_t b_ = __builtin_shufflevector(__builtin_bit_cast(v4i_t, Bt_[n][0]), __builtin_bit_cast(v4i_t, Bt_[n][1]), 0, 1, 2, 3, 4, 5, 6, 7); \
            acc[ai][bj][m][n] = __builtin_amdgcn_mfma_scale_f32_16x16x128_f8f6f4(b_, a_, acc[ai][bj][m][n], 0, 0, 0, 0x7f7f7f7f, 0, 0x7f7f7f7f); } \
        else { _Pragma("unroll") for (int k = 0; k < 2; ++k) acc[ai][bj][m][n] = __builtin_amdgcn_mfma_f32_16x16x32_bf16(Bt_[n][k], At[m][k], acc[ai][bj][m][n], 0, 0, 0); } } __builtin_amdgcn_s_setprio(0); } while (0)
#define PG8_WAIT_V(n) asm volatile("s_waitcnt vmcnt(" #n ")" ::: "memory")
#define PG8_WAIT_L(n) asm volatile("s_waitcnt lgkmcnt(" #n ")" ::: "memory")
#define PG8_BAR __builtin_amdgcn_s_barrier()
#define PG8_SCHED __builtin_amdgcn_sched_barrier(0)
#define PG8_VRAW(raw, u) do { _Pragma("unroll") for (int _i = 0; _i < 2; ++_i) { int _R, _C; stage_rc(tid * 16 + _i * 8192, _R, _C); _Pragma("unroll") for (int _h = 0; _h < 2; ++_h) raw[_h][_i] = S.a_raw(u, _h * HALF + _R); } } while (0)
#define PG8_VFIN(dst, raw, u) do { _Pragma("unroll") for (int _i = 0; _i < 2; ++_i) { int _R, _C; stage_rc(tid * 16 + _i * 8192, _R, _C); _Pragma("unroll") for (int _h = 0; _h < 2; ++_h) dst[_h][_i] = S.a_fin(u, _h * HALF + _R, raw[_h][_i]) + (unsigned)_C * 2u; } } while (0)
#define PG8_VOFF(dst, u) do { _Pragma("unroll") for (int _i = 0; _i < 2; ++_i) { int _R, _C; stage_rc(tid * 16 + _i * 8192, _R, _C); _Pragma("unroll") for (int _h = 0; _h < 2; ++_h) dst[_h][_i] = S.a_off(u, _h * HALF + _R) + (unsigned)_C * 2u; } } while (0)
    Unit cur, nxt; int ui = 0;
    if (!S.next(0, cur)) return;
    float pf_w = 0.f; int pf_d = 0;
    if constexpr (Epi::PREFETCH) { E.fetch(cur, tid, pf_w, pf_d); E.stash(0, tid, pf_w, pf_d); }
    f32x4 acc[2][2][4][2];
#pragma unroll
    for (int a = 0; a < 2; ++a)
#pragma unroll
        for (int b = 0; b < 2; ++b)
#pragma unroll
            for (int m = 0; m < 4; ++m)
#pragma unroll
                for (int n = 0; n < 2; ++n) acc[a][b][m][n] = (f32x4){0.f, 0.f, 0.f, 0.f};
    bf16x8 At[4][2], B0[2][2], B1[2][2];
    unsigned vc[2][2]; int vn[2][2];
    PG8_VOFF(vc, cur);
    const char* const Ab = (const char*)Abase;
    const char* cB = (const char*)Bt + (size_t)cur.bt * tstep;
    PG8_STAGE(PG8_SB(0, 0), cB, voffB); PG8_STAGE(PG8_SB(0, 1), cB + hstep, voffB); PG8_STAGE(PG8_SA(0, 0), Ab, vc[0]); PG8_STAGE(PG8_SA(0, 1), Ab, vc[1]);
    if (wr == 1) PG8_BAR;
    PG8_WAIT_V(2); PG8_BAR;
    PG8_STAGE(PG8_SB(1, 0), cB + kstep, voffB); PG8_STAGE(PG8_SA(1, 0), Ab + kstep, vc[0]); PG8_STAGE(PG8_SB(1, 1), cB + hstep + kstep, voffB);
    PG8_WAIT_V(6); PG8_BAR;
    for (;;) {
        const bool has_next = S.next(ui + 1, nxt);
        if constexpr (Epi::PREFETCH) { if (has_next) E.fetch(nxt, tid, pf_w, pf_d); }
        if constexpr (Sched::EARLY_VOFF) { if (has_next) { PG8_VRAW(vn, nxt); } }
        const char* nB = has_next ? (const char*)Bt + (size_t)nxt.bt * tstep : cB;
#pragma unroll 1
        for (int t = 0; t < nt; t += 2) {
            const bool last = (t == nt - 2);
            const char* a1 = Ab + (size_t)(t + 1) * kstep;
            const char* a2 = last ? Ab : Ab + (size_t)(t + 2) * kstep; const char* b2 = last ? nB : cB + (size_t)(t + 2) * kstep;
            const char* a3 = a2 + kstep; const char* b3 = b2 + kstep;
            PG8_LDB(B0, 0, 0); PG8_LDB(B1, 0, 1); PG8_SCHED; PG8_LDA(At, 0, 0); PG8_STAGE(PG8_SA(1, 1), a1, vc[1]);
            if (last && has_next) { if constexpr (Sched::EARLY_VOFF) { PG8_VFIN(vc, vn, nxt); } else { PG8_VOFF(vc, nxt); } }
            PG8_WAIT_V(8); PG8_WAIT_L(0); PG8_BAR; PG8_MMA(0, 0, At, B0); PG8_MMA(0, 1, At, B1); PG8_BAR; PG8_SCHED;
            PG8_LDA(At, 0, 1); PG8_STAGE(PG8_SB(0, 0), b2, voffB); PG8_STAGE(PG8_SB(0, 1), b2 + hstep, voffB); PG8_STAGE(PG8_SA(0, 0), a2, vc[0]);
            PG8_WAIT_V(8); PG8_WAIT_L(0); PG8_BAR; PG8_MMA(1, 0, At, B0); PG8_MMA(1, 1, At, B1); PG8_BAR; PG8_SCHED;
            PG8_LDB(B0, 1, 0); PG8_LDB(B1, 1, 1); PG8_SCHED; PG8_LDA(At, 1, 0); PG8_STAGE(PG8_SA(0, 1), a2, vc[1]);
            PG8_WAIT_V(8); PG8_WAIT_L(0); PG8_BAR; PG8_MMA(0, 0, At, B0); PG8_MMA(0, 1, At, B1); PG8_BAR; PG8_SCHED;
            PG8_LDA(At, 1, 1); PG8_STAGE(PG8_SB(1, 0), b3, voffB); PG8_STAGE(PG8_SB(1, 1), b3 + hstep, voffB); PG8_STAGE(PG8_SA(1, 0), a3, vc[0]);
            PG8_WAIT_V(8); PG8_WAIT_L(0); PG8_BAR; PG8_MMA(1, 0, At, B0); PG8_MMA(1, 1, At, B1); PG8_BAR; PG8_SCHED;
        }
        if (wr == 0) PG8_BAR;
        if constexpr (Epi::PREFETCH) { if (has_next) E.stash((ui + 1) & 1, tid, pf_w, pf_d); E(acc, cur, wr, wc, fr, fq, ui & 1); } else
        E(acc, cur, wr, wc, fr, fq);
#ifdef PROBE_DUPEPI
        if constexpr (Epi::ID == PROBE_DUPEPI) { asm volatile("" ::: "memory"); if constexpr (Epi::PREFETCH) E(acc, cur, wr, wc, fr, fq, ui & 1); else E(acc, cur, wr, wc, fr, fq); asm volatile("" ::: "memory"); }
#endif
        if (!has_next) break;
#pragma unroll
        for (int a = 0; a < 2; ++a)
#pragma unroll
            for (int b = 0; b < 2; ++b)
#pragma unroll
                for (int m = 0; m < 4; ++m)
#pragma unroll
                    for (int n = 0; n < 2; ++n) { typedef double d2_t __attribute__((ext_vector_type(2))); d2_t z_; asm volatile("v_mov_b64 %0, 0\n\tv_mov_b64 %1, 0" : "=v"(z_.x), "=v"(z_.y)); acc[a][b][m][n] = __builtin_bit_cast(f32x4, z_); }
        cur = nxt; cB = nB; ++ui;
        if (wr == 1) PG8_BAR;
    }
    PG8_WAIT_V(0);
    PG8_BAR;
#undef PG8_SA
#undef PG8_SB
#undef PG8_STAGE
#undef PG8_LDA
#undef PG8_LDB
#undef PG8_MMA
#undef PG8_WAIT_V
#undef PG8_WAIT_L
#undef PG8_BAR
#undef PG8_SCHED
#undef PG8_VOFF
#undef PG8_VRAW
#undef PG8_VFIN
}
}
namespace att {
#define ATT_LAS __attribute__((address_space(3)))
typedef unsigned short bf16_t;
using bf16x8 = __attribute__((ext_vector_type(8))) short;
using s16x4 = __attribute__((ext_vector_type(4))) short;
using f32x16 = __attribute__((ext_vector_type(16))) float;
using u32x4 = __attribute__((ext_vector_type(4))) unsigned;
typedef float f32x4 __attribute__((ext_vector_type(4)));
constexpr int PITCH = 512, SEQ = 4096, NH = 8, D = 64;
constexpr float LOG2E = 1.4426950408889634f;
constexpr int L_BUF = 16384  , L_BIAS = 32768, L_REL = 33280, L_WS = 34560, L_OST = 36608, LDS_BYTES = L_OST + 8 * 4096;
__device__ __forceinline__ int crow(int r, int hi) { return (r & 3) + 8 * (r >> 2) + 4 * hi; }
typedef float f32x2_t __attribute__((ext_vector_type(2))); typedef __bf16 bf16x2_t __attribute__((ext_vector_type(2)));
__device__ __forceinline__ unsigned cvtpk_s(float lo, float hi) { f32x2_t v = {lo, hi}; bf16x2_t b = __builtin_convertvector(v, bf16x2_t); return __builtin_bit_cast(unsigned, b); }
__device__ __forceinline__ unsigned short f2bf(float f) { unsigned u = __builtin_bit_cast(unsigned, f); return (unsigned short)((u + 0x7fffu + ((u >> 16) & 1u)) >> 16); }

template <int MODE>
__device__ __forceinline__ void attn_unit(int b, int h, int ub, const bf16_t* Q, const bf16_t* __restrict__ K, const bf16_t* __restrict__ V, bf16_t* O,
                                          const float* __restrict__ cum  , const float* __restrict__ rel  , ATT_LAS unsigned char* shm) {
    int tid_ = threadIdx.x; asm volatile("" : "+v"(tid_));
    const int tid = tid_, lane = tid & 63, r32 = lane & 31, hi = lane >> 5; const int wid = __builtin_amdgcn_readfirstlane(tid >> 6);
    const long rowbase = (long)b * SEQ; const int q0 = ub * 256;
    const bf16_t* Qw = Q + (rowbase + q0 + wid * 32) * PITCH + h * D;
    const bf16_t* Kh = K + rowbase * PITCH + h * D; const bf16_t* Vh = V + rowbase * PITCH + h * D;
    ATT_LAS float* biasl = (ATT_LAS float*)(shm + L_BIAS);
    ATT_LAS float* rell = (ATT_LAS float*)(shm + L_REL);
    ATT_LAS float* wsf = (ATT_LAS float*)(shm + L_WS) + wid * 64;
    int t_lo, t_hi, wt_lo, wt_hi, cw = 0;
    if (MODE == 0) { t_lo = 0; t_hi = (q0 + 256) / 64 - 1; wt_lo = 0; wt_hi = (q0 + wid * 32 + 31) / 64; }
    else { cw = 4 * ub + (wid >> 1); wt_lo = cw - 8 < 0 ? 0 : cw - 8; wt_hi = cw; t_lo = 4 * ub - 8 < 0 ? 0 : 4 * ub - 8; t_hi = 4 * ub + 3; }
    const float cq0 = (MODE == 0) ? cum[(b * NH + h) * SEQ + q0] : 0.f;
    const float rfar = (MODE == 1) ? rel[h * 257 + 256] * LOG2E : 0.f;
    bf16x8 qr[4];
#pragma unroll
    for (int d0 = 0; d0 < 4; ++d0) qr[d0] = *reinterpret_cast<const bf16x8*>(&Qw[(long)r32 * PITCH + d0 * 16 + hi * 8]);
    float mrun = -1e30f, lrun = 0.f; f32x16 o[2]; o[0] = f32x16{}; o[1] = f32x16{};
    const int qabs = q0 + wid * 32 + r32;
    const bf16_t* ksrc = Kh + (long)lane * PITCH + wid * 8;
    const bf16_t* vsrc = Vh + (long)(16 * (wid & 3) + (lane >> 2)) * PITCH + (wid >> 2) * 32 + (lane & 3) * 8;
    ATT_LAS unsigned char* kdst = shm + wid * 1024 + lane * 16;
    ATT_LAS unsigned char* vdst = shm + 8192 + wid * 1024 + lane * 16;
    const unsigned vb0 = (unsigned)(uintptr_t)(shm + 8192) + ((lane >> 4) & 1) * 32 + (lane & 3) * 8 + (4 * hi + ((lane & 15) >> 2)) * 64;
    const ATT_LAS unsigned char* kb0 = shm + hi * 1024 + r32 * 16;
    __syncthreads();
    if (MODE == 1) { for (int i = tid; i < 257; i += 512) rell[i] = rel[h * 257 + i] * LOG2E; }
    { const u32x4 k0 = *(const u32x4*)(ksrc + (long)t_lo * 64 * PITCH), v0 = *(const u32x4*)(vsrc + (long)t_lo * 64 * PITCH);
      *(ATT_LAS u32x4*)(kdst + (t_lo & 1) * L_BUF) = k0; *(ATT_LAS u32x4*)(vdst + (t_lo & 1) * L_BUF) = v0;
      if (MODE == 0 && wid == 0) biasl[(t_lo & 1) * 64 + lane] = (cq0 - cum[(b * NH + h) * SEQ + t_lo * 64 + lane]) * LOG2E; }
    u32x4 kreg = (u32x4){0u, 0u, 0u, 0u}, vreg = kreg; float cj = 0.f;
    if (t_lo < t_hi) { kreg = *(const u32x4*)(ksrc + (long)(t_lo + 1) * 64 * PITCH); vreg = *(const u32x4*)(vsrc + (long)(t_lo + 1) * 64 * PITCH);
        if (MODE == 0 && wid == 0) cj = cum[(b * NH + h) * SEQ + (t_lo + 1) * 64 + lane]; }
    for (int t = t_lo; t <= t_hi; ++t) {
        __syncthreads();
        if (t < t_hi) {
            *(ATT_LAS u32x4*)(kdst + ((t + 1) & 1) * L_BUF) = kreg; *(ATT_LAS u32x4*)(vdst + ((t + 1) & 1) * L_BUF) = vreg;
            if (MODE == 0 && wid == 0) biasl[((t + 1) & 1) * 64 + lane] = (cq0 - cj) * LOG2E;
            if (t + 1 < t_hi) { kreg = *(const u32x4*)(ksrc + (long)(t + 2) * 64 * PITCH); vreg = *(const u32x4*)(vsrc + (long)(t + 2) * 64 * PITCH);
                if (MODE == 0 && wid == 0) cj = cum[(b * NH + h) * SEQ + (t + 2) * 64 + lane]; }
        }
        if (t >= wt_lo && t <= wt_hi) {
            const int bo = (t & 1) * L_BUF; const ATT_LAS unsigned char* kb = kb0 + bo; const unsigned vbt = vb0 + bo;
            f32x16 p0 = f32x16{}, p1 = f32x16{};
            if (MODE == 0) {
                const ATT_LAS float* bl = biasl + (t & 1) * 64 + 4 * hi;
#pragma unroll
                for (int g = 0; g < 4; ++g) { const f32x4 bA = *(const ATT_LAS f32x4*)(bl + 8 * g), bB = *(const ATT_LAS f32x4*)(bl + 32 + 8 * g);
#pragma unroll
                    for (int i = 0; i < 4; ++i) { p0[4 * g + i] = bA[i]; p1[4 * g + i] = bB[i]; } }
            }
#pragma unroll
            for (int d0 = 0; d0 < 4; ++d0) {
                const bf16x8 b0 = *reinterpret_cast<const ATT_LAS bf16x8*>(kb + d0 * 2048);
                const bf16x8 b1 = *reinterpret_cast<const ATT_LAS bf16x8*>(kb + d0 * 2048 + 512);
                p0 = __builtin_amdgcn_mfma_f32_32x32x16_bf16(b0, qr[d0], p0, 0, 0, 0); p1 = __builtin_amdgcn_mfma_f32_32x32x16_bf16(b1, qr[d0], p1, 0, 0, 0); }
            float cst = 0.f;
            if (MODE == 0) {
                if (64 * t + 63 > q0 + wid * 32) {
#pragma unroll
                    for (int r = 0; r < 16; ++r) { const int kv = 64 * t + crow(r, hi); p0[r] = (kv > qabs) ? -INFINITY : p0[r]; p1[r] = (kv + 32 > qabs) ? -INFINITY : p1[r]; } }
            } else {
                if (cw - t <= 2) {
#pragma unroll
                    for (int r = 0; r < 16; ++r) { const int kv = 64 * t + crow(r, hi); int d0_ = qabs - kv; int d1_ = d0_ - 32;
                        d0_ = d0_ < -128 ? -128 : (d0_ > 128 ? 128 : d0_); d1_ = d1_ < -128 ? -128 : (d1_ > 128 ? 128 : d1_);
                        p0[r] += rell[d0_ + 128]; p1[r] += rell[d1_ + 128]; }
                } else cst = rfar;
            }
            float rm = fmaxf(fmaxf(p0[0], p0[1]), p0[2]);
#pragma unroll
            for (int r = 3; r < 15; r += 2) rm = fmaxf(fmaxf(rm, p0[r]), p0[r + 1]);
            rm = fmaxf(rm, p0[15]);
#pragma unroll
            for (int r = 0; r < 16; r += 2) rm = fmaxf(fmaxf(rm, p1[r]), p1[r + 1]);
            rm = fmaxf(rm, __shfl_xor(rm, 32)) + cst;
            const float mnew = fmaxf(mrun, rm); const float alpha = __builtin_amdgcn_exp2f(mrun - mnew); const bool grew = mnew > mrun; mrun = mnew;
            const float sub = mnew - cst;
            float sacc = 0.f;
#pragma unroll
            for (int r = 0; r < 16; ++r) { p0[r] = __builtin_amdgcn_exp2f(p0[r] - sub); p1[r] = __builtin_amdgcn_exp2f(p1[r] - sub); sacc += p0[r] + p1[r]; }
            lrun = lrun * alpha + sacc;
            if (__any(grew)) {
                if (hi == 0) wsf[r32] = alpha;
                asm volatile("s_waitcnt lgkmcnt(0)" ::: "memory");
#pragma unroll
                for (int r = 0; r < 16; ++r) { const float f = wsf[crow(r, hi)]; o[0][r] *= f; o[1][r] *= f; }
            }
            u32x4 pw0, pw1, pw2, pw3;
            pw0 = (u32x4){cvtpk_s(p0[0], p0[1]), cvtpk_s(p0[2], p0[3]), cvtpk_s(p0[4], p0[5]), cvtpk_s(p0[6], p0[7])};
            pw1 = (u32x4){cvtpk_s(p0[8], p0[9]), cvtpk_s(p0[10], p0[11]), cvtpk_s(p0[12], p0[13]), cvtpk_s(p0[14], p0[15])};
            pw2 = (u32x4){cvtpk_s(p1[0], p1[1]), cvtpk_s(p1[2], p1[3]), cvtpk_s(p1[4], p1[5]), cvtpk_s(p1[6], p1[7])};
            pw3 = (u32x4){cvtpk_s(p1[8], p1[9]), cvtpk_s(p1[10], p1[11]), cvtpk_s(p1[12], p1[13]), cvtpk_s(p1[14], p1[15])};
            const bf16x8 pa0 = __builtin_bit_cast(bf16x8, pw0), pa1 = __builtin_bit_cast(bf16x8, pw1), pa2 = __builtin_bit_cast(bf16x8, pw2), pa3 = __builtin_bit_cast(bf16x8, pw3);
#pragma unroll
            for (int d0 = 0; d0 < 2; ++d0) { s16x4 lo[4], hh[4];
#pragma unroll
                for (int ks = 0; ks < 4; ++ks) {
                    asm volatile("ds_read_b64_tr_b16 %0,%1 offset:%c2" : "=&v"(lo[ks]) : "v"(vbt), "i"(d0 * 4096 + ks * 1024) : "memory");
                    asm volatile("ds_read_b64_tr_b16 %0,%1 offset:%c2" : "=&v"(hh[ks]) : "v"(vbt), "i"(d0 * 4096 + ks * 1024 + 512) : "memory"); }
                asm volatile("s_waitcnt lgkmcnt(0)" ::: "memory"); __builtin_amdgcn_sched_barrier(0);
#define ATT_PK(k) (bf16x8){lo[k][0], lo[k][1], lo[k][2], lo[k][3], hh[k][0], hh[k][1], hh[k][2], hh[k][3]}
                o[d0] = __builtin_amdgcn_mfma_f32_32x32x16_bf16(pa0, ATT_PK(0), o[d0], 0, 0, 0);
                o[d0] = __builtin_amdgcn_mfma_f32_32x32x16_bf16(pa1, ATT_PK(1), o[d0], 0, 0, 0);
                o[d0] = __builtin_amdgcn_mfma_f32_32x32x16_bf16(pa2, ATT_PK(2), o[d0], 0, 0, 0);
                o[d0] = __builtin_amdgcn_mfma_f32_32x32x16_bf16(pa3, ATT_PK(3), o[d0], 0, 0, 0);
#undef ATT_PK
            }
        }
    }
    lrun += __shfl_xor(lrun, 32);
    if (hi == 0) wsf[32 + r32] = lrun;
    asm volatile("s_waitcnt lgkmcnt(0)" ::: "memory");
    float rli[16];
#pragma unroll
    for (int r = 0; r < 16; ++r) rli[r] = __builtin_amdgcn_rcpf(wsf[32 + crow(r, hi)]);
    bf16_t* Ow = O + (rowbase + q0 + wid * 32) * PITCH + h * D;
    { ATT_LAS bf16_t* stg = (ATT_LAS bf16_t*)(shm + L_OST) + wid * 2048;
#pragma unroll
      for (int r = 0; r < 16; ++r) { const int orow = crow(r, hi);
#pragma unroll
          for (int d0 = 0; d0 < 2; ++d0) stg[orow * 64 + d0 * 32 + r32] = f2bf(o[d0][r] * rli[r]); }
      asm volatile("s_waitcnt lgkmcnt(0)" ::: "memory");
#pragma unroll
      for (int i = 0; i < 4; ++i) { const int row = i * 8 + (lane >> 3), ch = lane & 7; const u32x4 v = *(const ATT_LAS u32x4*)(stg + row * 64 + ch * 8); *(u32x4*)(Ow + (long)row * PITCH + ch * 8) = v; } }
}
}
namespace fox {
using bf16=__hip_bfloat16;
using bf16x8=__attribute__((ext_vector_type(8)))short;
using s16x4=__attribute__((ext_vector_type(4)))short;
using f32x16=__attribute__((ext_vector_type(16)))float;
using u32x4=__attribute__((ext_vector_type(4)))unsigned;
constexpr int SEQ=4096,D=64,DM=512;
constexpr int NW=8,QBLK=32,QB=QBLK*NW,KVBLK=64,NQB=SEQ/QB;
constexpr int ATTN_PITCH=DM, ATTN_UNIT_ROWS=QB;
__device__ __forceinline__ int crow(int r,int hi){return (r&3)+8*(r>>2)+4*hi;}
#define SBAR() __builtin_amdgcn_sched_barrier(0)
__device__ __forceinline__ void cmask(f32x16&p0,f32x16&p1,int jb,int qrel,int hi){
  const float NEG=-INFINITY; int kb=64*jb+4*hi;
  #pragma unroll
  for(int r=0;r<16;++r){int kv=kb+(r&3)+8*(r>>2); if(kv>qrel)p0[r]=NEG; if(kv+32>qrel)p1[r]=NEG;}
}

constexpr int NSLOT=3, SLOTB=8192;
constexpr int LDS_K=0, LDS_V=NSLOT*SLOTB, LDS_WS=2*NSLOT*SLOTB, LDS_OST=LDS_WS+NW*64*4, LDS_BIAS=LDS_OST+NW*4096, LDS_BYTES=LDS_BIAS+SEQ*8+1024;
constexpr float C2=0.125f*1.4426950408889634f;
__device__ __forceinline__ void glds16(const void*gsrc,unsigned lds_dst){unsigned keep;
  asm volatile("s_mov_b32 %0, m0\n\ts_mov_b32 m0, %2\n\ts_nop 0\n\tglobal_load_lds_dwordx4 %1, off\n\ts_mov_b32 m0, %0":"=&s"(keep):"v"(gsrc),"s"(lds_dst):"memory");}
__device__ __forceinline__ float max3f(float a,float b,float c){float r;asm("v_max3_f32 %0, %1, %2, %3":"=v"(r):"v"(a),"v"(b),"v"(c));return r;}
__device__ __forceinline__ float max2f(float a,float b){float r;asm("v_max_f32_e32 %0, %1, %2":"=v"(r):"v"(a),"v"(b));return r;}
__device__ __forceinline__ float fadd_s(float a,float b){float r;asm("v_add_f32_e32 %0, %1, %2":"=v"(r):"v"(a),"v"(b));return r;}
__device__ __forceinline__ float fsub_s(float a,float b){float r;asm("v_sub_f32_e32 %0, %1, %2":"=v"(r):"v"(a),"v"(b));return r;}
typedef float f32x2_t __attribute__((ext_vector_type(2))); typedef __bf16 bf16x2_t __attribute__((ext_vector_type(2)));
__device__ __forceinline__ unsigned cvtpk_s(float lo,float hi){f32x2_t v={lo,hi};bf16x2_t b=__builtin_convertvector(v,bf16x2_t);return __builtin_bit_cast(unsigned,b);}
#define WAIT_BAR(N) asm volatile("s_waitcnt vmcnt(" #N ") lgkmcnt(0)\n\ts_barrier":::"memory")

__device__ __forceinline__ void qkt(f32x16&p0,f32x16&p1,const char*Kslot,const bf16x8*qr,bf16x8 ka0,bf16x8 ka1,bf16x8 qa,int r32,int hi){
  p0=__builtin_amdgcn_mfma_f32_32x32x16_bf16(ka0,qa,f32x16{},0,0,0);p1=__builtin_amdgcn_mfma_f32_32x32x16_bf16(ka1,qa,f32x16{},0,0,0);
  const char*kb=Kslot+hi*1024+r32*16;
  #pragma unroll
  for(int d0=0;d0<4;++d0){
    const bf16x8 b0=*reinterpret_cast<const bf16x8*>(kb+d0*2048);
    const bf16x8 b1=*reinterpret_cast<const bf16x8*>(kb+d0*2048+512);
    p0=__builtin_amdgcn_mfma_f32_32x32x16_bf16(b0,qr[d0],p0,0,0,0);p1=__builtin_amdgcn_mfma_f32_32x32x16_bf16(b1,qr[d0],p1,0,0,0);}
}
typedef __attribute__((address_space(3))) const char* lds_cptr;
typedef short v4i16_t __attribute__((ext_vector_type(4)));
__device__ __forceinline__ void kload8(bf16x8*kf,lds_cptr kp){
  kf[0]=*(const __attribute__((address_space(3))) bf16x8*)(kp);      kf[1]=*(const __attribute__((address_space(3))) bf16x8*)(kp+512);
  kf[2]=*(const __attribute__((address_space(3))) bf16x8*)(kp+2048); kf[3]=*(const __attribute__((address_space(3))) bf16x8*)(kp+2560);
  kf[4]=*(const __attribute__((address_space(3))) bf16x8*)(kp+4096); kf[5]=*(const __attribute__((address_space(3))) bf16x8*)(kp+4608);
  kf[6]=*(const __attribute__((address_space(3))) bf16x8*)(kp+6144); kf[7]=*(const __attribute__((address_space(3))) bf16x8*)(kp+6656);
}
__device__ __forceinline__ void kload2(bf16x8*kf,lds_cptr kp,int j){ kf[2*j]=*(const __attribute__((address_space(3))) bf16x8*)(kp+j*2048); kf[2*j+1]=*(const __attribute__((address_space(3))) bf16x8*)(kp+j*2048+512); }
__device__ __forceinline__ s16x4 vtr(lds_cptr p){ return __builtin_bit_cast(s16x4,__builtin_amdgcn_ds_read_tr16_b64_v4i16((__attribute__((address_space(3))) v4i16_t*)p)); }
__device__ __forceinline__ float rowmax(const f32x16&p0,const f32x16&p1){
  float a=max3f(p0[0],p0[1],p1[0]),b=max3f(p0[2],p0[3],p1[1]);a=max3f(a,p1[2],p1[3]);
  #pragma unroll
  for(int r=4;r<16;r+=4){a=max3f(a,p0[r],p0[r+1]);b=max3f(b,p0[r+2],p0[r+3]);a=max3f(a,p1[r],p1[r+1]);b=max3f(b,p1[r+2],p1[r+3]);}
  const float m=max2f(a,b);
  auto rr=__builtin_amdgcn_permlane32_swap(__float_as_uint(m),__float_as_uint(m),false,false);
  return max2f(__uint_as_float(rr[0]),__uint_as_float(rr[1]));
}
__device__ __forceinline__ void pv(f32x16*o,int vb,bf16x8 pa0,bf16x8 pa1,bf16x8 pa2,bf16x8 pa3){
  #pragma unroll
  for(int d0=0;d0<2;++d0){s16x4 lo[4],hi[4];
    #pragma unroll
    for(int ks=0;ks<4;++ks){
      asm volatile("ds_read_b64_tr_b16 %0,%1 offset:%c2":"=&v"(lo[ks]):"v"(vb),"i"(d0*4096+ks*1024):"memory");
      asm volatile("ds_read_b64_tr_b16 %0,%1 offset:%c2":"=&v"(hi[ks]):"v"(vb),"i"(d0*4096+ks*1024+512):"memory");}
    asm volatile("s_waitcnt lgkmcnt(0)":::"memory");SBAR();
    #define PK(k) (bf16x8){lo[k][0],lo[k][1],lo[k][2],lo[k][3],hi[k][0],hi[k][1],hi[k][2],hi[k][3]}
    o[d0]=__builtin_amdgcn_mfma_f32_32x32x16_bf16(pa0,PK(0),o[d0],0,0,0);
    o[d0]=__builtin_amdgcn_mfma_f32_32x32x16_bf16(pa1,PK(1),o[d0],0,0,0);
    o[d0]=__builtin_amdgcn_mfma_f32_32x32x16_bf16(pa2,PK(2),o[d0],0,0,0);
    o[d0]=__builtin_amdgcn_mfma_f32_32x32x16_bf16(pa3,PK(3),o[d0],0,0,0);
    #undef PK
  }
}

__device__ __forceinline__ void split3(float x,unsigned&h,unsigned&m,unsigned&l){
  h=cvtpk_s(x,0.f)&0xffffu; const float r1=x-__uint_as_float(h<<16); m=cvtpk_s(r1,0.f)&0xffffu; const float r2=r1-__uint_as_float(m<<16); l=cvtpk_s(r2,0.f)&0xffffu; }
__device__ __forceinline__ bf16x8 mk_kaug(float bias,int hi){ unsigned h,m,l; split3(bias,h,m,l); u32x4 w; w.x=hi?0u:(h|(m<<16)); w.y=hi?0u:(l|0x3f800000u); w.z=hi?0u:0x3f803f80u; w.w=0u; return __builtin_bit_cast(bf16x8,w); }
__device__ __forceinline__ bf16x8 mk_qaug(float nref,int hi){ unsigned h,m,l; split3(nref,h,m,l); u32x4 w; w.x=hi?0u:0x3f803f80u; w.y=hi?0u:(0x3f80u|(h<<16)); w.z=hi?0u:(m|(l<<16)); w.w=0u; return __builtin_bit_cast(bf16x8,w); }
__device__ __forceinline__ void prep_kaug(const float*__restrict__ cumbh,char*shm){
  unsigned long long*tabU=(unsigned long long*)(shm+LDS_BIAS);
  int t0_=threadIdx.x; asm volatile("":"+v"(t0_));
  for(int i=t0_;i<SEQ+64;i+=NW*64){ const float b=(i<SEQ)?-cumbh[i]*1.4426950408889634f:0.f; unsigned h,m,l; split3(b,h,m,l); tabU[i]=(unsigned long long)(h|(m<<16))|((unsigned long long)(l|0x3f800000u)<<32); }
}
#ifndef ATTN_STORE16
#define ATTN_STORE16(p,v) (*(u32x4*)(p)=(v))
#endif
template<int THRL> __device__ __forceinline__ void attn_unit(int b,int h,int qb,const bf16*Q,const bf16*__restrict__ K,const bf16*__restrict__ V,bf16*O,const float*__restrict__ cumbh,char*shm){
  int tid_=threadIdx.x; asm volatile("":"+v"(tid_)); const int tid=tid_,lane=tid&63,r32=lane&31,hi=lane>>5; const int wid=__builtin_amdgcn_readfirstlane(tid>>6);
  const long rowbase=(long)b*SEQ; const int q0=qb*QB;
  const bf16*Qw=Q+(rowbase+q0+wid*QBLK)*DM+h*D;
  const bf16*Kh=K+rowbase*DM+h*D,*Vh=V+rowbase*DM+h*D;
  const unsigned lds0=(unsigned)(uintptr_t)shm;
  float*wsf=(float*)(shm+LDS_WS)+wid*64;
  const bf16*ksrc=Kh+(long)lane*DM+wid*8;
  const bf16*vsrc=Vh+(long)(16*(wid&3)+(lane>>2))*DM+(wid>>2)*32+(lane&3)*8;
  const unsigned kdst=lds0+LDS_K+wid*1024, vdst=lds0+LDS_V+wid*1024;
  #define DMA_K(t,slot) glds16(ksrc+(long)(t)*KVBLK*DM,(unsigned)__builtin_amdgcn_readfirstlane(kdst+(slot)))
  #define DMA_V(t,slot) glds16(vsrc+(long)(t)*KVBLK*DM,(unsigned)__builtin_amdgcn_readfirstlane(vdst+(slot)))
  const int vb0=(int)(lds0+LDS_V)+((lane>>4)&1)*32+(lane&3)*8+(4*hi+((lane&15)>>2))*64;
  const char*Kbase=shm+LDS_K; bf16x8 kf[8];
  const lds_cptr shm3=(lds_cptr)shm; const lds_cptr kp0=shm3+LDS_K+hi*1024+r32*16; const lds_cptr vp0=shm3+LDS_V+((lane>>4)&1)*32+(lane&3)*8+(4*hi+((lane&15)>>2))*64;
  const int NT=(q0+QB)/KVBLK;
  const unsigned long long*tabU=(const unsigned long long*)(shm+LDS_BIAS);
  const float bq=-cumbh[q0+wid*QBLK+r32]*1.4426950408889634f;
  asm volatile("s_waitcnt vmcnt(0)":::"memory");
  DMA_K(0,0);DMA_V(0,0);DMA_K(1,SLOTB);
  bf16x8 qr[4];
  #pragma unroll
  for(int d0=0;d0<4;++d0)qr[d0]=*reinterpret_cast<const bf16x8*>(&Qw[(long)r32*DM+d0*16+hi*8]);
  float mhat=0.f,l_reg=0.f;f32x16 o[2];o[0]=f32x16{};o[1]=f32x16{}; bf16x8 qaug=mk_qaug(-bq,hi),kaug0,kaug1;
  #define KAUG(tn) do{ const unsigned long long e0_=tabU[(tn)*KVBLK+r32],e1_=tabU[(tn)*KVBLK+32+r32]; \
    u32x4 w0_,w1_; w0_.x=hi?0u:(unsigned)e0_; w0_.y=hi?0u:(unsigned)(e0_>>32); w0_.z=hi?0u:0x3f803f80u; w0_.w=0u; w1_.x=hi?0u:(unsigned)e1_; w1_.y=hi?0u:(unsigned)(e1_>>32); w1_.z=w0_.z; w1_.w=0u; \
    kaug0=__builtin_bit_cast(bf16x8,w0_); kaug1=__builtin_bit_cast(bf16x8,w1_); }while(0)
  const int qrel=wid*QBLK+r32;
  #define CMASK(P0,P1,t) do{int jb_=(t)-(NT-4); if(jb_>=0)cmask(P0,P1,jb_,qrel,hi);}while(0)
  bool resc=false;
  #define START(P0,P1) do{ const float rm=rowmax(P0,P1); resc=false; \
    if(__builtin_expect(__any(rm>(float)THRL),0)){ const float dl=__builtin_fmaxf(rm,0.f); mhat=fadd_s(mhat,dl); \
      _Pragma("unroll") for(int r=0;r<16;++r){P0[r]=fsub_s(P0[r],dl);P1[r]=fsub_s(P1[r],dl);} \
      qaug=mk_qaug(-(bq+mhat),hi); } \
    _Pragma("unroll") for(int r=0;r<16;++r)P0[r]=__builtin_amdgcn_exp2f(P0[r]); }while(0)
  #define RESC() do{ if(resc){ asm volatile("s_waitcnt lgkmcnt(0)":::"memory"); \
      _Pragma("unroll") for(int d_=0;d_<2;++d_) _Pragma("unroll") for(int r=0;r<16;++r)o[d_][r]*=wsf[crow(r,hi)]; } }while(0)
  f32x16 pA0,pA1,pB0,pB1;
  int sl_prev=0,sl_cur=0,sl_next=SLOTB;
  #define ROT() do{sl_prev=sl_cur;sl_cur=sl_next;sl_next=(sl_next==(NSLOT-1)*SLOTB)?0:sl_next+SLOTB;}while(0)
  DMA_K(2,2*SLOTB);
  WAIT_BAR(3);
  KAUG(0);
  qkt(pA0,pA1,Kbase,qr,kaug0,kaug1,qaug,r32,hi);asm volatile("s_nop 15\n\ts_nop 7":"+v"(pA0),"+v"(pA1));CMASK(pA0,pA1,0);
  START(pA0,pA1);
  _Pragma("unroll") for(int r=0;r<16;++r)pA1[r]=__builtin_amdgcn_exp2f(pA1[r]);
  WAIT_BAR(0);
  DMA_K(3,0);DMA_V(1,SLOTB);
  ROT();
  kload8(kf,kp0+sl_cur);
  KAUG(1);
  WAIT_BAR(2);
  s16x4 vlo[8],vhi[8]; u32x4 pw0,pw1,pw2,pw3;
  #define PKW(P,B) cvtpk_s(P[B],P[B+1])
  #define PAF(k) __builtin_bit_cast(bf16x8,pw##k)
  #define VFR(i) (bf16x8){vlo[i][0],vlo[i][1],vlo[i][2],vlo[i][3],vhi[i][0],vhi[i][1],vhi[i][2],vhi[i][3]}
  #define PIN(x) asm volatile("":"+v"(x))
  #define MX3(a,b,c) __builtin_fmaxf(__builtin_fmaxf((a),(b)),(c))
  #define GAPA(MF,A0,A1,A2,A3,W0,W1,PW) do{ MF; sacc+=A0; sacc+=A1; sacc+=A2; sacc+=A3; PIN(sacc); W0; W1; PIN(PW); SBAR(); }while(0)
  #define EX(v) __builtin_amdgcn_exp2f(v)
  #define GAPB(MF,X,B) do{ MF; X[B]=EX(X[B]); X[B+1]=EX(X[B+1]); X[B+2]=EX(X[B+2]); X[B+3]=EX(X[B+3]); PIN(X); SBAR(); }while(0)
  #define VRD(i) do{ vlo[i]=vtr(vp_+(((i)>>2)*4096+((i)&3)*1024)); vhi[i]=vtr(vp_+(((i)>>2)*4096+((i)&3)*1024+512)); }while(0)
  #define KRD(G,j) do{ if(G){ kload2(kf,kp0+sl_next,j); SBAR(); } }while(0)
  #define STEP(C0,C1,P0,P1,t,GK,GV,GL) do{ SBAR(); \
    C0=__builtin_amdgcn_mfma_f32_32x32x16_bf16(kaug0,qaug,f32x16{},0,0,0); C1=__builtin_amdgcn_mfma_f32_32x32x16_bf16(kaug1,qaug,f32x16{},0,0,0); SBAR(); \
    const lds_cptr vp_=vp0+sl_prev; \
    VRD(0); SBAR(); float sacc=(P0[0]+P0[1]); \
    GAPA(C0=__builtin_amdgcn_mfma_f32_32x32x16_bf16(kf[0],qr[0],C0,0,0,0), P0[2],P0[3],P0[4],P0[5],     pw0[0]=PKW(P0,0), pw0[1]=PKW(P0,2), pw0); \
    VRD(4); SBAR(); GAPA(C1=__builtin_amdgcn_mfma_f32_32x32x16_bf16(kf[1],qr[0],C1,0,0,0), P0[6],P0[7],P0[8],P0[9],     pw0[2]=PKW(P0,4), pw0[3]=PKW(P0,6), pw0); \
    VRD(1); SBAR(); GAPA(C0=__builtin_amdgcn_mfma_f32_32x32x16_bf16(kf[2],qr[1],C0,0,0,0),   P0[10],P0[11],P0[12],P0[13], pw1[0]=PKW(P0,8), pw1[1]=PKW(P0,10), pw1); \
    VRD(5); SBAR(); GAPA(C1=__builtin_amdgcn_mfma_f32_32x32x16_bf16(kf[3],qr[1],C1,0,0,0),   P0[14],P0[15],P1[0],P1[1],   pw1[2]=PKW(P0,12),pw1[3]=PKW(P0,14), pw1); \
    VRD(2); SBAR(); GAPA(C0=__builtin_amdgcn_mfma_f32_32x32x16_bf16(kf[4],qr[2],C0,0,0,0),   P1[2],P1[3],P1[4],P1[5],     pw2[0]=PKW(P1,0), pw2[1]=PKW(P1,2), pw2); \
    VRD(6); SBAR(); GAPA(C1=__builtin_amdgcn_mfma_f32_32x32x16_bf16(kf[5],qr[2],C1,0,0,0),   P1[6],P1[7],P1[8],P1[9],     pw2[2]=PKW(P1,4), pw2[3]=PKW(P1,6), pw2); \
    VRD(3); SBAR(); GAPA(C0=__builtin_amdgcn_mfma_f32_32x32x16_bf16(kf[6],qr[3],C0,0,0,0),   P1[10],P1[11],P1[12],P1[13], pw3[0]=PKW(P1,8), pw3[1]=PKW(P1,10), pw3); \
    VRD(7); SBAR(); GAPA(C1=__builtin_amdgcn_mfma_f32_32x32x16_bf16(kf[7],qr[3],C1,0,0,0),   P1[14],P1[15],0.f,0.f,       pw3[2]=PKW(P1,12),pw3[3]=PKW(P1,14), pw3); \
    l_reg+=sacc; \
    if(GK){DMA_K((t)+3,sl_cur);} if(GV){DMA_V((t)+1,sl_next);} \
    CMASK(C0,C1,t); \
    { float a=MX3(C0[0],C0[1],C1[0]),b=MX3(C0[2],C0[3],C1[1]); a=MX3(a,C1[2],C1[3]); \
      _Pragma("unroll") for(int r=4;r<16;r+=4){a=MX3(a,C0[r],C0[r+1]);b=MX3(b,C0[r+2],C0[r+3]);a=MX3(a,C1[r],C1[r+1]);b=MX3(b,C1[r+2],C1[r+3]);} \
      float rm=__builtin_fmaxf(a,b); { auto rr=__builtin_amdgcn_permlane32_swap(__float_as_uint(rm),__float_as_uint(rm),false,false); rm=__builtin_fmaxf(__uint_as_float(rr[0]),__uint_as_float(rr[1])); } \
      resc=false; \
      if(__builtin_expect(__any(rm>(float)THRL),0)){ const float dl=__builtin_fmaxf(rm,0.f); mhat+=dl; \
        _Pragma("unroll") for(int r=0;r<16;++r){C0[r]-=dl;C1[r]-=dl;} \
        qaug=mk_qaug(-(bq+mhat),hi); \
        const float f=__builtin_amdgcn_exp2f(-dl); l_reg*=f; if(hi==0)wsf[r32]=f; resc=true; } } \
    SBAR(); \
    GAPB(o[0]=__builtin_amdgcn_mfma_f32_32x32x16_bf16(PAF(0),VFR(0),o[0],0,0,0), C0,0); \
    GAPB(o[1]=__builtin_amdgcn_mfma_f32_32x32x16_bf16(PAF(0),VFR(4),o[1],0,0,0), C0,4); \
    KRD(GL,0); GAPB(o[0]=__builtin_amdgcn_mfma_f32_32x32x16_bf16(PAF(1),VFR(1),o[0],0,0,0), C0,8); \
    KRD(GL,1); GAPB(o[1]=__builtin_amdgcn_mfma_f32_32x32x16_bf16(PAF(1),VFR(5),o[1],0,0,0), C0,12); \
    KRD(GL,2); GAPB(o[0]=__builtin_amdgcn_mfma_f32_32x32x16_bf16(PAF(2),VFR(2),o[0],0,0,0), C1,0); \
    KRD(GL,3); GAPB(o[1]=__builtin_amdgcn_mfma_f32_32x32x16_bf16(PAF(2),VFR(6),o[1],0,0,0), C1,4); \
    GAPB(o[0]=__builtin_amdgcn_mfma_f32_32x32x16_bf16(PAF(3),VFR(3),o[0],0,0,0), C1,8); \
    GAPB(o[1]=__builtin_amdgcn_mfma_f32_32x32x16_bf16(PAF(3),VFR(7),o[1],0,0,0), C1,12); \
    }while(0)
  int t=1;
  #undef CMASK
  #define CMASK(P0,P1,t) do{}while(0)
  for(;t+5<NT;t+=2){
    STEP(pB0,pB1,pA0,pA1,t,true,true,true);     KAUG(t+1); WAIT_BAR(2); RESC(); ROT();
    STEP(pA0,pA1,pB0,pB1,t+1,true,true,true);   KAUG(t+2); WAIT_BAR(2); RESC(); ROT();
  }
  #undef CMASK
  #define CMASK(P0,P1,t) do{int jb_=(t)-(NT-4); if(jb_>=0)cmask(P0,P1,jb_,qrel,hi);}while(0)
  #define ENDW(tt) do{ if((tt)+3<NT){WAIT_BAR(2);} else if((tt)+2<NT){WAIT_BAR(1);} else {WAIT_BAR(0);} }while(0)
  for(;t+1<NT;t+=2){
    STEP(pB0,pB1,pA0,pA1,t,(t+3<NT),(t+1<NT),(t+1<NT));       KAUG(t+1); ENDW(t);   RESC(); ROT();
    STEP(pA0,pA1,pB0,pB1,t+1,(t+4<NT),(t+2<NT),(t+2<NT));     KAUG(t+2); ENDW(t+1); RESC(); ROT();
  }
  STEP(pB0,pB1,pA0,pA1,NT-1,false,false,false); RESC();
  { float sacc=pB0[0]+pB0[1]; _Pragma("unroll") for(int r=2;r<16;++r)sacc+=pB0[r]; _Pragma("unroll") for(int r=0;r<16;++r)sacc+=pB1[r]; l_reg+=sacc;
    pw0=(u32x4){PKW(pB0,0),PKW(pB0,2),PKW(pB0,4),PKW(pB0,6)};pw1=(u32x4){PKW(pB0,8),PKW(pB0,10),PKW(pB0,12),PKW(pB0,14)};pw2=(u32x4){PKW(pB1,0),PKW(pB1,2),PKW(pB1,4),PKW(pB1,6)};pw3=(u32x4){PKW(pB1,8),PKW(pB1,10),PKW(pB1,12),PKW(pB1,14)};
    SBAR(); pv(o,vb0+sl_cur,PAF(0),PAF(1),PAF(2),PAF(3)); }
  #undef PKW
  #undef PAF
  #undef VFR
  #undef PIN
  #undef MX3
  #undef GAPA
  #undef GAPB
  #undef EX
  #undef VRD
  #undef KRD
  #undef STEP
  #undef ENDW
  {auto rr=__builtin_amdgcn_permlane32_swap(__float_as_uint(l_reg),__float_as_uint(l_reg),false,false);l_reg=__uint_as_float(rr[0])+__uint_as_float(rr[1]);}
  if(hi==0)wsf[32+r32]=l_reg;asm volatile("s_waitcnt lgkmcnt(0)":::"memory");
  float rli[16];
  #pragma unroll
  for(int r=0;r<16;++r)rli[r]=__builtin_amdgcn_rcpf(wsf[32+crow(r,hi)]);
  bf16*Ow=O+(rowbase+q0+wid*QBLK)*DM+h*D;
  { bf16*stg=(bf16*)(shm+LDS_OST)+wid*2048;
    #pragma unroll
    for(int r=0;r<16;++r){const int orow=crow(r,hi);
      #pragma unroll
      for(int d0=0;d0<2;++d0)stg[orow*64+d0*32+r32]=__float2bfloat16(o[d0][r]*rli[r]);}
    asm volatile("s_waitcnt lgkmcnt(0)":::"memory");
    #pragma unroll
    for(int i=0;i<4;++i){const int row=i*8+(lane>>3),ch=lane&7; const u32x4 v=*(const u32x4*)(stg+row*64+ch*8); ATTN_STORE16(Ow+(long)row*DM+ch*8,v);} }
  asm volatile("s_waitcnt lgkmcnt(0)\n\ts_barrier":::"memory");
  #undef DMA_K
  #undef KAUG
  #undef DMA_V
  #undef CMASK
  #undef START
  #undef RESC
  #undef ROT
}
#undef SBAR
#undef WAIT_BAR
}
constexpr int NWAVES = 8;
constexpr int T = 32768, D = 1024, SEQ = 4096, DEPTH = 2, NIN = 5128;
constexpr int NSLOT = 9, MAXTILES = 1216;
constexpr float SLOT_SCALE = 16.0f;
constexpr float EPS = 1e-6f;
constexpr float C2 = 0.125f * 1.4426950408889634f;
constexpr size_t MiB = 1u << 20;
constexpr size_t WS_CTL = 0, CTL_ZERO_BYTES = 1 * MiB;
constexpr size_t WS_MOD = 1 * MiB;
constexpr size_t WS_GAIN = 1 * MiB + 512 * 1024;
constexpr size_t WS_LOGF = 2 * MiB;
constexpr size_t WS_CUM = 3 * MiB;
constexpr size_t WS_META = 6 * MiB;
constexpr size_t WS_WIN = 22 * MiB;
constexpr size_t WS_WING = 22 * MiB;
constexpr size_t WS_HQ = 575 * MiB;
constexpr size_t WS_WPROJ = 32 * MiB;
constexpr size_t WS_WOUT = 34 * MiB;
constexpr size_t WS_MQ = 236 * MiB;
constexpr float M_SCALE = 16.0f;
constexpr size_t WS_WR = 36 * MiB;
constexpr size_t WS_WGU = 37 * MiB;
constexpr size_t WS_WD = 102 * MiB;
constexpr int HP = 1088;
constexpr size_t WS_H = 135 * MiB;
constexpr size_t WS_H2 = 287 * MiB;
constexpr size_t WS_QKV = 204 * MiB;
constexpr size_t QKV_STRIDE = (size_t)T * 512;
constexpr size_t WS_G = 396 * MiB;
constexpr size_t G_STRIDE = (size_t)T * 1024;
constexpr size_t WS_H2Q = 352 * MiB;
constexpr float WGU_SCALE = 64.0f;
constexpr float ACT_SCALE = 8.0f;
constexpr size_t WS_ACT = 135 * MiB;
constexpr size_t WS_SLOT = 287 * MiB;
constexpr size_t WS_LTK = 575 * MiB, WS_LW = 583 * MiB;
constexpr int LCAP = 32768;
constexpr size_t WS_END = 607 * MiB;
static_assert(WS_SLOT + (size_t)T * NSLOT * 1024 <= WS_LTK && WS_ACT + (size_t)MAXTILES * 256 * 512 <= WS_H2 && WS_H2 + (size_t)(T + 256) * 2048 <= WS_LTK && WS_G + 2 * G_STRIDE * 2 <= WS_LTK && WS_QKV + 6 * QKV_STRIDE * 2 <= WS_G && WS_LW + (size_t)64 * LCAP * 4 <= WS_END, "ws map");
constexpr int CW_BAR = 4096, CW_GCNT = 8192;
constexpr int RING_BYTES = 131072, LDSCTL_OFF = RING_BYTES, MISC_OFF = LDSCTL_OFF + 320, LDS_BYTES = 147456;

#define GAS __attribute__((address_space(1)))
#define LAS __attribute__((address_space(3)))
typedef unsigned short bf16;
typedef unsigned v4u __attribute__((ext_vector_type(4)));
typedef unsigned v2u __attribute__((ext_vector_type(2)));
typedef float f32x4 __attribute__((ext_vector_type(4)));
#define LDS_WAIT() asm volatile("s_waitcnt lgkmcnt(0)" ::: "memory")
__device__ __forceinline__ unsigned f2bf(float f) { unsigned u = __builtin_bit_cast(unsigned, f); return (u + 0x7fffu + ((u >> 16) & 1u)) >> 16; }
__device__ __forceinline__ unsigned pk2(float lo, float hi) { return f2bf(lo) | (f2bf(hi) << 16); }
__device__ __forceinline__ float bflo(unsigned w) { return __uint_as_float(w << 16); }
__device__ __forceinline__ float bfhi(unsigned w) { return __uint_as_float(w & 0xffff0000u); }
__device__ __forceinline__ float sigmoidf_(float x) { return __builtin_amdgcn_rcpf(1.0f + __expf(-x)); }

#define XB_TMO      128
#define XB_XCNT(j)  (256  + 64 * (j))
#define XB_XSUB(j)  (1280 + 64 * (j))
#define XB_XGEN(j)  (2304 + 64 * (j))
#define XB_TOP      3328
#define XB_TOPGEN   3392
#define XCD_BAR_WORDS 3456
#define XB_SPIN_CAP (1u << 18)
__device__ __forceinline__ unsigned xb_ld(unsigned* p)              { return __hip_atomic_load(p, __ATOMIC_RELAXED, __HIP_MEMORY_SCOPE_AGENT); }
__device__ __forceinline__ unsigned xb_add(unsigned* p, unsigned v) { return __hip_atomic_fetch_add(p, v, __ATOMIC_RELAXED, __HIP_MEMORY_SCOPE_AGENT); }
__device__ __forceinline__ unsigned xb_xcc_id() { return (unsigned)__builtin_amdgcn_s_getreg((3 << 11) | 20) & 0xFu; }
#define XB_SPIN(cond, bar) do { unsigned _sp = 0; while (cond) { __builtin_amdgcn_s_sleep(1); \
    if ((++_sp & 255u) == 0u) { if (xb_ld(&(bar)[XB_TMO])) break; if (_sp > XB_SPIN_CAP) { atomicAdd(&(bar)[XB_TMO], 1u); break; } } } } while (0)
struct XcdBarrier { unsigned* bar; unsigned x; volatile LAS unsigned* st; };
__device__ __forceinline__ XcdBarrier xcd_barrier_post(unsigned* bar, volatile LAS unsigned* st) {
    XcdBarrier b; b.bar = bar; b.x = xb_xcc_id(); b.st = st;
    if (threadIdx.x == 0) (void)xb_add(&bar[XB_XCNT(b.x)], 1u);
    return b;
}
__device__ __forceinline__ void xcd_barrier_complete(unsigned* bar, unsigned x, unsigned& nloc, unsigned& nx) {
    const unsigned G = gridDim.x * gridDim.y * gridDim.z;
    unsigned sum, cnt, mine, sp = 0u;
    for (;;) {
        sum = 0u; cnt = 0u; mine = 0u;
#pragma unroll
        for (unsigned j = 0; j < 16; ++j) { const unsigned c = xb_ld(&bar[XB_XCNT(j)]); sum += c; cnt += (c > 0u) ? 1u : 0u; mine = (j == x) ? c : mine; }
        if (sum == G) break;
        __builtin_amdgcn_s_sleep(1);
        if ((++sp & 255u) == 0u) { if (xb_ld(&bar[XB_TMO])) break; if (sp > XB_SPIN_CAP) { atomicAdd(&bar[XB_TMO], 1u); break; } }
    }
    nloc = mine > 0u ? mine : 1u; nx = cnt > 0u ? cnt : 1u;
}
__device__ __forceinline__ void xcd_barrier(const XcdBarrier& b) {
    asm volatile("s_waitcnt vmcnt(0)" ::: "memory");
    __syncthreads();
    if (threadIdx.x == 0) {
        unsigned* bar = b.bar;
        __builtin_amdgcn_s_waitcnt(0);
        unsigned nloc = b.st[0], nx = b.st[1];
        if (nloc == 0u) { xcd_barrier_complete(bar, b.x, nloc, nx); b.st[0] = nloc; b.st[1] = nx; }
        const unsigned old = xb_add(&bar[XB_XSUB(b.x)], 1u);
        const unsigned gen = old / nloc;
        if (old + 1u == (gen + 1u) * nloc) {
            __builtin_amdgcn_fence(__ATOMIC_RELEASE, "agent");
            asm volatile("s_waitcnt vmcnt(0)" ::: "memory");
            const unsigned og = xb_add(&bar[XB_TOP], 1u);
            const unsigned tg = og / nx;
            if (og + 1u == (tg + 1u) * nx) xb_add(&bar[XB_TOPGEN], 1u);
            else XB_SPIN(xb_ld(&bar[XB_TOPGEN]) == tg, bar);
            __builtin_amdgcn_fence(__ATOMIC_ACQUIRE, "agent");
            xb_add(&bar[XB_XGEN(b.x)], 1u);
            asm volatile("s_waitcnt vmcnt(0)" ::: "memory");
        } else {
            XB_SPIN(xb_ld(&bar[XB_XGEN(b.x)]) == gen, bar);
            __builtin_amdgcn_fence(__ATOMIC_ACQUIRE, "agent");
            asm volatile("s_waitcnt vmcnt(0)" ::: "memory");
        }
    }
    __syncthreads();
}

__device__ __forceinline__ float wave_sum(float v) {
#pragma unroll
    for (int o = 1; o < 64; o <<= 1) v += __shfl_xor(v, o);
    return v;
}
template <bool PERMD = false, bool OUT8 = false>
__device__ __forceinline__ void transpose_item(const float* __restrict__ W, int ldw, int col0, int k0, bf16* WT, int ldt, int drow0, LAS float* scr, int lane) {
#pragma unroll 8
    for (int i = 0; i < 32; ++i) { const int kk = 2 * i + (lane >> 5); scr[kk * 33 + (lane & 31)] = W[(size_t)(k0 + kk) * ldw + col0 + (lane & 31)]; }
    LDS_WAIT(); asm volatile("" ::: "memory");
    const int c = lane & 7;
#pragma unroll
    for (int j = 0; j < 4; ++j) { const int n = (lane >> 3) + 8 * j; const LAS float* s = scr + (8 * c) * 33 + n;
        v4u o; o.x = pk2(s[0 * 33], s[1 * 33]); o.y = pk2(s[2 * 33], s[3 * 33]); o.z = pk2(s[4 * 33], s[5 * 33]); o.w = pk2(s[6 * 33], s[7 * 33]);
        const int nr = PERMD ? (128 * ((n >> 3) & 1) + 8 * (n >> 4) + (n & 7)) : n;
        if (OUT8) { int q0 = __builtin_amdgcn_cvt_pk_fp8_f32(s[0 * 33] * WGU_SCALE, s[1 * 33] * WGU_SCALE, 0, false); q0 = __builtin_amdgcn_cvt_pk_fp8_f32(s[2 * 33] * WGU_SCALE, s[3 * 33] * WGU_SCALE, q0, true);
            int q1 = __builtin_amdgcn_cvt_pk_fp8_f32(s[4 * 33] * WGU_SCALE, s[5 * 33] * WGU_SCALE, 0, false); q1 = __builtin_amdgcn_cvt_pk_fp8_f32(s[6 * 33] * WGU_SCALE, s[7 * 33] * WGU_SCALE, q1, true);
            v2u o8; o8.x = (unsigned)q0; o8.y = (unsigned)q1; *(v2u*)((unsigned char*)WT + (size_t)(drow0 + nr) * ldt + k0 + 8 * c) = o8; }
        else *(v4u*)(WT + (size_t)(drow0 + nr) * ldt + k0 + 8 * c) = o; }
    LDS_WAIT(); asm volatile("" ::: "memory");
}

struct Args { const float* in[24]; float* out; unsigned char* ws; };
struct ArgView {
    __device__ __forceinline__ const float* operator[](int k) const { asm volatile("" : "+s"(k)); return ((const float* const __attribute__((address_space(4)))*)__builtin_amdgcn_kernarg_segment_ptr())[k]; } };
struct ArgsV { ArgView in;
    __device__ __forceinline__ float* outp() const { return (float*)in[24]; }
    __device__ __forceinline__ unsigned char* wsp() const { return (unsigned char*)in[25]; } };

enum { I_X = 0, I_C, I_ADAW, I_ADAB, I_MIXG, I_WIN, I_BF, I_QNA, I_KNA, I_QNB, I_KNB, I_REL, I_WPA, I_WPB, I_WOUT, I_FFNG, I_WR, I_RB, I_WGE, I_WUE, I_WDE, I_WGS, I_WUS, I_WDS };

struct CvtItem { const float* src; unsigned char* dst; int ldw, ldt, drow0, k0; bool perm, out8; };
__device__ __forceinline__ void cvt_decode(const ArgsV& a, int l, int it, CvtItem& c) {
    constexpr int I_IN = 2560, I_PA = 256, I_PB = 256, I_OUT = 512, I_R = 32, I_GU = 65 * 256;
    unsigned char* ws = a.wsp();
    int r = it; c.perm = false; c.out8 = true;
    if (r < I_IN) { const int kb = r / 160, nb = r % 160, pn = nb >> 3, g = nb & 7, lc0 = 64 * (g & 3) + 32 * (g >> 2);
        const int zc0 = pn < 12 ? 256 * pn + lc0 : 3080 + 256 * (pn - 12) + lc0;
        c.ldw = NIN; c.k0 = 64 * kb; c.src = a.in[I_WIN] + (size_t)l * D * NIN + (size_t)c.k0 * NIN + zc0; c.dst = ws + WS_WING; c.ldt = 1024; c.drow0 = 256 * pn + 32 * g; return; }
    r -= I_IN;
    if (r < I_PA + I_PB) { const int second = r >= I_PA; const int r1 = second ? r - I_PA : r; const int kb = r1 / 32, nb = r1 % 32;
        c.ldw = 1024; c.k0 = 64 * kb; c.src = a.in[second ? I_WPB : I_WPA] + (size_t)l * 512 * 1024 + (size_t)c.k0 * 1024 + 32 * nb; c.dst = ws + WS_WPROJ; c.ldt = 1024; c.drow0 = (second ? 1024 : 0) + 32 * nb; c.out8 = false; return; }
    r -= I_PA + I_PB;
    if (r < I_OUT) { const int kb = r / 32, nb = r % 32;
        c.ldw = 1024; c.k0 = 64 * kb; c.src = a.in[I_WOUT] + (size_t)l * 1024 * 1024 + (size_t)c.k0 * 1024 + 32 * nb; c.dst = ws + WS_WOUT; c.ldt = 1024; c.drow0 = 32 * nb; return; }
    r -= I_OUT;
    if (r < I_R) { const int kb = r / 2, nb = r % 2;
        c.ldw = 64; c.k0 = 64 * kb; c.src = a.in[I_WR] + (size_t)l * 1024 * 64 + (size_t)c.k0 * 64 + 32 * nb; c.dst = ws + WS_WR; c.ldt = 2048; c.drow0 = 32 * nb; c.out8 = false; return; }
    r -= I_R;
    if (r < I_GU) { const int e = r >> 8, r1 = r & 255, mat = r1 >> 7, r2 = r1 & 127, kb = r2 >> 3, nb = r2 & 7;
        const float* src = e < 64 ? a.in[mat ? I_WUE : I_WGE] + ((size_t)l * 64 + e) * 262144 : a.in[mat ? I_WUS : I_WGS] + (size_t)l * 262144;
        c.ldw = 256; c.k0 = 64 * kb; c.src = src + (size_t)c.k0 * 256 + 32 * nb; c.dst = ws + WS_WGU; c.ldt = 1024; c.drow0 = e * 512 + 256 * (nb >> 2) + 128 * mat + 32 * (nb & 3); return; }
    r -= I_GU;
    { const int e = r >> 7, r1 = r & 127, kb = r1 >> 5, nb = r1 & 31;
        const float* src = e < 64 ? a.in[I_WDE] + ((size_t)l * 64 + e) * 262144 : a.in[I_WDS] + (size_t)l * 262144;
        const int q = nb & 7;
        c.ldw = 1024; c.k0 = 64 * kb; c.src = src + (size_t)c.k0 * 1024 + 32 * nb; c.dst = ws + WS_WD; c.ldt = 256; c.drow0 = e * 1024 + 256 * (nb >> 3) + 32 * (q >> 1) + 16 * (q & 1); c.perm = true; }
}
__device__ __forceinline__ void cvt_load(const CvtItem& c, int lane, f32x4 (&t)[8]) {
    const float* q = c.src + (size_t)(lane >> 3) * c.ldw + 4 * (lane & 7);
#pragma unroll
    for (int i = 0; i < 8; ++i) t[i] = *(const f32x4*)(q + (size_t)(8 * i) * c.ldw);
}
__device__ __forceinline__ void cvt_store(const CvtItem& c, const f32x4 (&t)[8], LAS float* scr, int lane) {
    { LAS float* d = scr + (lane >> 3) * 33 + 4 * (lane & 7);
#pragma unroll
      for (int i = 0; i < 8; ++i) { d[(8 * i) * 33 + 0] = t[i].x; d[(8 * i) * 33 + 1] = t[i].y; d[(8 * i) * 33 + 2] = t[i].z; d[(8 * i) * 33 + 3] = t[i].w; } }
    LDS_WAIT(); asm volatile("" ::: "memory");
    const int cc = lane & 7;
#pragma unroll
    for (int j = 0; j < 4; ++j) { const int n = (lane >> 3) + 8 * j; const LAS float* s = scr + (8 * cc) * 33 + n;
        const int nr = c.perm ? (128 * ((n >> 3) & 1) + 8 * (n >> 4) + (n & 7)) : n;
        if (c.out8) { int q0 = __builtin_amdgcn_cvt_pk_fp8_f32(s[0 * 33] * WGU_SCALE, s[1 * 33] * WGU_SCALE, 0, false); q0 = __builtin_amdgcn_cvt_pk_fp8_f32(s[2 * 33] * WGU_SCALE, s[3 * 33] * WGU_SCALE, q0, true);
            int q1 = __builtin_amdgcn_cvt_pk_fp8_f32(s[4 * 33] * WGU_SCALE, s[5 * 33] * WGU_SCALE, 0, false); q1 = __builtin_amdgcn_cvt_pk_fp8_f32(s[6 * 33] * WGU_SCALE, s[7 * 33] * WGU_SCALE, q1, true);
            v2u o8; o8.x = (unsigned)q0; o8.y = (unsigned)q1; *(v2u*)(c.dst + (size_t)(c.drow0 + nr) * c.ldt + c.k0 + 8 * cc) = o8; }
        else { v4u o; o.x = pk2(s[0 * 33], s[1 * 33]); o.y = pk2(s[2 * 33], s[3 * 33]); o.z = pk2(s[4 * 33], s[5 * 33]); o.w = pk2(s[6 * 33], s[7 * 33]);
            *(v4u*)(c.dst + (size_t)(c.drow0 + nr) * c.ldt + 2 * (c.k0 + 8 * cc)) = o; } }
    LDS_WAIT(); asm volatile("" ::: "memory");
}
constexpr int CVT_NITEMS = 2560 + 256 + 256 + 512 + 32 + 65 * 256 + 65 * 128;
__device__ __forceinline__ void convert_weights(const ArgsV& a, int l, LAS unsigned char* lds, int gw, int NGW, int wave, int lane, int it_lo = 0, int it_hi = CVT_NITEMS) {
    LAS float* scr = (LAS float*)(lds + wave * 8448);
    const int NITEMS = it_hi;
    int it = it_lo + gw; if (it >= NITEMS) return;
    CvtItem cur; f32x4 tn[8];
    cvt_decode(a, l, it, cur); cvt_load(cur, lane, tn);
    for (;;) {
        f32x4 tc[8];
#pragma unroll
        for (int i = 0; i < 8; ++i) tc[i] = tn[i];
        const int itn = it + NGW; const bool more = itn < NITEMS; CvtItem nxt = cur;
        if (more) { cvt_decode(a, l, itn, nxt); cvt_load(nxt, lane, tn); }
        cvt_store(cur, tc, scr, lane);
        if (!more) break;
        cur = nxt; it = itn;
    }
}

__device__ __forceinline__ void mod_unit(const ArgsV& a, int u, LAS unsigned char* lds, int tid, int wave, int lane) {
    LAS float* cact = (LAS float*)(lds + 73728);
    LAS float* part = (LAS float*)(lds + 73728 + 32768);
    for (int i = tid; i < 8192; i += 512) { const float c = a.in[I_C][i]; cact[i] = c * sigmoidf_(c); }
    __syncthreads();
    const int l = u / 96, cg = u % 96;
    const float* W = a.in[I_ADAW] + (size_t)l * D * 6144 + 64 * cg + lane;
    float acc[8];
#pragma unroll
    for (int b = 0; b < 8; ++b) acc[b] = 0.f;
#pragma unroll 16
    for (int k = 128 * wave; k < 128 * wave + 128; ++k) { const float wv = W[(size_t)k * 6144];
#pragma unroll
        for (int b = 0; b < 8; ++b) acc[b] += cact[b * 1024 + k] * wv; }
#pragma unroll
    for (int b = 0; b < 8; ++b) part[(wave * 8 + b) * 64 + lane] = acc[b];
    __syncthreads();
    { const int b = tid >> 6; float s = 0.f;
#pragma unroll
      for (int w = 0; w < 8; ++w) s += part[(w * 8 + b) * 64 + lane];
      ((float*)(a.wsp() + WS_MOD))[(size_t)(l * 8 + b) * 6144 + 64 * cg + lane] = s + a.in[I_ADAB][l * 6144 + 64 * cg + lane]; }
    __syncthreads();
}

typedef float f32x2_ __attribute__((ext_vector_type(2)));
__device__ __forceinline__ void add_fp8x16(f32x4 (&s)[4], const v4u w) {
    const unsigned ww[4] = {w.x, w.y, w.z, w.w};
#pragma unroll
    for (int q = 0; q < 4; ++q) { const f32x2_ lo = __builtin_amdgcn_cvt_pk_f32_fp8((int)ww[q], false), hi = __builtin_amdgcn_cvt_pk_f32_fp8((int)ww[q], true); s[q].x += lo.x; s[q].y += lo.y; s[q].z += hi.x; s[q].w += hi.y; }
}
constexpr int XP = 2048;
__device__ __forceinline__ void xrow_load16(const bf16* xb, size_t m, int lane, f32x4 (&v)[4]) {
    const v4u w0 = *(const v4u*)(xb + m * XP + 16 * lane), w1 = *(const v4u*)(xb + m * XP + 16 * lane + 8);
    v[0] = (f32x4){bflo(w0.x), bfhi(w0.x), bflo(w0.y), bfhi(w0.y)}; v[1] = (f32x4){bflo(w0.z), bfhi(w0.z), bflo(w0.w), bfhi(w0.w)};
    v[2] = (f32x4){bflo(w1.x), bfhi(w1.x), bflo(w1.y), bfhi(w1.y)}; v[3] = (f32x4){bflo(w1.z), bfhi(w1.z), bflo(w1.w), bfhi(w1.w)}; }
__device__ __forceinline__ void xrow_store16(bf16* xb, size_t m, int lane, const f32x4 (&v)[4]) {
    v4u w0, w1; w0.x = pg8::cvt_pk_bf16(v[0].x, v[0].y); w0.y = pg8::cvt_pk_bf16(v[0].z, v[0].w); w0.z = pg8::cvt_pk_bf16(v[1].x, v[1].y); w0.w = pg8::cvt_pk_bf16(v[1].z, v[1].w);
    w1.x = pg8::cvt_pk_bf16(v[2].x, v[2].y); w1.y = pg8::cvt_pk_bf16(v[2].z, v[2].w); w1.z = pg8::cvt_pk_bf16(v[3].x, v[3].y); w1.w = pg8::cvt_pk_bf16(v[3].z, v[3].w);
    *(v4u*)(xb + m * XP + 16 * lane) = w0; *(v4u*)(xb + m * XP + 16 * lane + 8) = w1; }
__device__ __forceinline__ void reduce_rows(const ArgsV& a, int l, int row_lo, int row_hi, int gw, int NGW, int lane) {
    const float* mod = (const float*)(a.wsp() + WS_MOD);
    const unsigned char* slots = (const unsigned char*)(a.wsp() + WS_SLOT);
    for (int m = row_lo + gw; m < row_hi; m += NGW) {
        const int b = m >> 12;
        const float* g2 = mod + (size_t)(l * 8 + b) * 6144 + 5120 + 16 * lane;
        float* xr = a.outp() + (size_t)m * D + 16 * lane;
        f32x4 s[4], xv[4]; xrow_load16((const bf16*)a.outp(), (size_t)m, lane, xv);
#pragma unroll
        for (int q = 0; q < 4; ++q) s[q] = (f32x4){0.f, 0.f, 0.f, 0.f};
#pragma unroll
        for (int k = 0; k < NSLOT; ++k) add_fp8x16(s, *(const v4u*)(slots + ((size_t)m * NSLOT + k) * 1024 + 16 * lane));
#pragma unroll
        for (int q = 0; q < 4; ++q) { const f32x4 g = *(const f32x4*)(g2 + 4 * q); xv[q] = xv[q] + g * s[q] * (1.0f / SLOT_SCALE); }
        asm volatile("" ::: "memory");
#pragma unroll
        for (int q = 0; q < 4; ++q) *(f32x4*)(xr + 4 * q) = xv[q];
    }
}

constexpr int MF_GA = RING_BYTES + 1024, MF_GB = MF_GA + 4096, MF_RSTD = MF_GB + 4096;
static_assert(MF_RSTD + 512 <= LDS_BYTES, "MoE-front tables fit above the ring");
template <int WHICH, bool FOLD>
__device__ __forceinline__ void norm_rows(const ArgsV& a, int l, LAS unsigned char* lds, int gw, int lane) {
    constexpr int NR = 2;
    const float* mod = (const float*)(a.wsp() + WS_MOD);
    bf16* H = (bf16*)(a.wsp() + (WHICH == 0 ? WS_H : WS_H2));
    const LAS float* wfl = (const LAS float*)(lds + 73728);
    const int m0 = 16 * gw, b = m0 >> 12;
    const float* gsrc = a.in[WHICH == 0 ? I_MIXG : I_FFNG] + l * D;
    const float* sh = mod + (size_t)(l * 8 + b) * 6144 + (WHICH == 0 ? 0 : 3072);
    const float* sc = sh + 1024;
    constexpr bool fold = FOLD;
    constexpr bool XB = FOLD || WHICH == 1;
    const int cb = XB ? 16 * lane : 4 * lane, cs = XB ? 4 : 256;
    f32x4 gA[4], gB[4];
#pragma unroll
    for (int jj = 0; jj < 4; ++jj) { const int c = cb + cs * jj; const f32x4 g = *(const f32x4*)(gsrc + c), s = *(const f32x4*)(sc + c); gA[jj] = g * (s + 1.0f); gB[jj] = *(const f32x4*)(sh + c); }
    const float* xsrc = a.in[I_X]; bf16* xb = (bf16*)a.outp();
    v4u xraw[NR][2];
    constexpr bool PFX = XB && !FOLD;
    if constexpr (PFX) {
#pragma unroll
        for (int r = 0; r < NR; ++r) { xraw[r][0] = *(const v4u*)(xb + (size_t)(m0 + r) * XP + 16 * lane); xraw[r][1] = *(const v4u*)(xb + (size_t)(m0 + r) * XP + 16 * lane + 8); } }
#pragma unroll 1
    for (int rq = 0; rq < 16 / NR; ++rq) { const int mb = m0 + NR * rq;
        f32x4 v[NR][4];
#pragma unroll
        for (int r = 0; r < NR; ++r) {
            if constexpr (XB && !PFX) xrow_load16(xb, (size_t)(mb + r), lane, v[r]);
            else if constexpr (PFX) { const v4u w0 = xraw[r][0], w1 = xraw[r][1];
                v[r][0] = (f32x4){bflo(w0.x), bfhi(w0.x), bflo(w0.y), bfhi(w0.y)}; v[r][1] = (f32x4){bflo(w0.z), bfhi(w0.z), bflo(w0.w), bfhi(w0.w)};
                v[r][2] = (f32x4){bflo(w1.x), bfhi(w1.x), bflo(w1.y), bfhi(w1.y)}; v[r][3] = (f32x4){bflo(w1.z), bfhi(w1.z), bflo(w1.w), bfhi(w1.w)};
                const int mn = (rq + 1 < 16 / NR) ? mb + NR : mb;
                xraw[r][0] = *(const v4u*)(xb + (size_t)(mn + r) * XP + 16 * lane); xraw[r][1] = *(const v4u*)(xb + (size_t)(mn + r) * XP + 16 * lane + 8); }
            else {
#pragma unroll
                for (int jj = 0; jj < 4; ++jj) v[r][jj] = *(const f32x4*)(xsrc + (size_t)(mb + r) * D + cb + cs * jj); } }
        if (fold) {
            const unsigned char* slots = (const unsigned char*)(a.wsp() + WS_SLOT); const float* g2 = mod + (size_t)((l - 1) * 8 + b) * 6144 + 5120 + 16 * lane;
#pragma unroll
            for (int r = 0; r < NR; ++r) { f32x4 s[4];
#pragma unroll
                for (int q = 0; q < 4; ++q) s[q] = (f32x4){0.f, 0.f, 0.f, 0.f};
#pragma unroll
                for (int k = 0; k < NSLOT; ++k) add_fp8x16(s, *(const v4u*)(slots + ((size_t)(mb + r) * NSLOT + k) * 1024 + 16 * lane));
#pragma unroll
                for (int jj = 0; jj < 4; ++jj) v[r][jj] = v[r][jj] + *(const f32x4*)(g2 + 4 * jj) * s[jj] * (1.0f / SLOT_SCALE);
                xrow_store16(xb, (size_t)(mb + r), lane, v[r]);
                asm volatile("" ::: "memory"); }
        }
        float ss[NR];
#pragma unroll
        for (int r = 0; r < NR; ++r) { ss[r] = 0.f;
#pragma unroll
            for (int jj = 0; jj < 4; ++jj) ss[r] += (v[r][jj].x * v[r][jj].x + v[r][jj].y * v[r][jj].y) + (v[r][jj].z * v[r][jj].z + v[r][jj].w * v[r][jj].w); }
#pragma unroll
        for (int o = 1; o < 64; o <<= 1)
#pragma unroll
            for (int r = 0; r < NR; ++r) ss[r] += __shfl_xor(ss[r], o);
#pragma unroll
        for (int r = 0; r < NR; ++r) { const float rstd = __builtin_amdgcn_rsqf(ss[r] * (1.0f / D) + EPS);
            if (WHICH == 1 && lane == 0) ((LAS float*)(lds + MF_RSTD))[(gw & 7) * 16 + NR * rq + r] = rstd;
            unsigned qv[4];
#pragma unroll
            for (int jj = 0; jj < 4; ++jj) { v[r][jj] = v[r][jj] * rstd * gA[jj] + gB[jj];
                int q = __builtin_amdgcn_cvt_pk_fp8_f32(v[r][jj].x, v[r][jj].y, 0, false); q = __builtin_amdgcn_cvt_pk_fp8_f32(v[r][jj].z, v[r][jj].w, q, true); qv[jj] = (unsigned)q; }
            unsigned char* const hrow = a.wsp() + (WHICH == 1 ? WS_H2Q : WS_HQ) + (size_t)(mb + r) * D;
            if constexpr (XB) *(v4u*)(hrow + 16 * lane) = (v4u){qv[0], qv[1], qv[2], qv[3]};
            else {
#pragma unroll
                for (int jj = 0; jj < 4; ++jj) *(unsigned*)(hrow + cb + cs * jj) = qv[jj]; } }
        if (WHICH == 0) {
            float fv[8 * NR];
#pragma unroll
            for (int i = 0; i < 8 * NR; ++i) fv[i] = 0.f;
#pragma unroll
            for (int j = 0; j < 8; ++j) {
#pragma unroll
                for (int jj = 0; jj < 4; ++jj) { const f32x4 w = *(const LAS f32x4*)(wfl + j * 1024 + cb + cs * jj);
#pragma unroll
                    for (int r = 0; r < NR; ++r) fv[r * 8 + j] += (v[r][jj].x * w.x + v[r][jj].y * w.y) + (v[r][jj].z * w.z + v[r][jj].w * w.w); }
                if (j & 1) asm volatile("" ::: "memory"); }
            constexpr int NST = (NR == 4) ? 5 : 4;
#pragma unroll
            for (int s = 0; s < NST; ++s) { const bool bit = (lane >> s) & 1;
#pragma unroll
                for (int j = 0; j < ((4 * NR) >> s); ++j) { const float lo = fv[2 * j], hi = fv[2 * j + 1]; const float snd = bit ? lo : hi, kp = bit ? hi : lo; fv[j] = kp + __shfl_xor(snd, 1 << s); } }
            float f = fv[0];
            if (NR == 2) f += __shfl_xor(f, 16);
            f += __shfl_xor(f, 32);
            if (lane < 8 * NR) { const int r = lane >> 3, j = lane & 7; f += a.in[I_BF][l * 8 + j];
                const float ls = fminf(f, 0.f) - log1pf(__expf(-fabsf(f)));
                ((float*)(a.wsp() + WS_LOGF))[(size_t)(b * 8 + j) * SEQ + ((mb + r) & (SEQ - 1))] = ls; }
        }
    }
}

__device__ __forceinline__ void route_block(const ArgsV& a, int l, int blk, LAS unsigned char* lds, const LAS float* lg, int tid) {
    LAS int* cntl = (LAS int*)(lds + 34816); LAS int* basel = (LAS int*)(lds + 34816 + 256);
    if (tid < 64) cntl[tid] = 0;
    __syncthreads();
    const int tkl = tid >> 2, part = tid & 3;
    int idx[8]; float wv[8]; int myrk0 = 0, myrk1 = 0;
    {
        const float* rb = a.in[I_RB] + l * 64 + 16 * part;
        float sc[16], bs[16];
#pragma unroll
        for (int q = 0; q < 4; ++q) { const f32x4 bb = *(const f32x4*)(rb + 4 * q);
#pragma unroll
            for (int i = 0; i < 4; ++i) { const float v = lg[tkl * 65 + 16 * part + 4 * q + i]; sc[4 * q + i] = sigmoidf_(v); bs[4 * q + i] = sc[4 * q + i] + bb[i]; } }
        float gl[2];
#pragma unroll
        for (int g = 0; g < 2; ++g) { float m1 = -INFINITY, m2 = -INFINITY;
#pragma unroll
            for (int jj = 0; jj < 8; ++jj) { const float v = bs[8 * g + jj]; if (v > m1) { m2 = m1; m1 = v; } else if (v > m2) { m2 = v; } }
            gl[g] = m1 + m2; }
        float gs[8];
#pragma unroll
        for (int q = 0; q < 4; ++q) { gs[2 * q] = __shfl(gl[0], (tid & ~3) + q); gs[2 * q + 1] = __shfl(gl[1], (tid & ~3) + q); }
        unsigned gmask = 0u;
#pragma unroll
        for (int p = 0; p < 4; ++p) { float best = -INFINITY; int bi = 0;
#pragma unroll
            for (int g = 0; g < 8; ++g) { const bool ok = !((gmask >> g) & 1u) && gs[g] > best; best = ok ? gs[g] : best; bi = ok ? g : bi; }
            gmask |= 1u << bi; }
#pragma unroll
        for (int e = 0; e < 16; ++e) bs[e] = ((gmask >> (2 * part + (e >> 3))) & 1u) ? bs[e] : -INFINITY;
        float wsum = 0.f;
#pragma unroll
        for (int p = 0; p < 8; ++p) { float best = -INFINITY; int bi = 16 * part; float bsc = 0.f;
#pragma unroll
            for (int e = 0; e < 16; ++e) { const bool ok = bs[e] > best; best = ok ? bs[e] : best; bi = ok ? 16 * part + e : bi; bsc = ok ? sc[e] : bsc; }
#pragma unroll
            for (int st = 1; st < 4; st <<= 1) { const float ov = __shfl_xor(best, st), os = __shfl_xor(bsc, st); const int oi = __shfl_xor(bi, st);
                const bool take = (ov > best) || (ov == best && oi < bi); best = take ? ov : best; bi = take ? oi : bi; bsc = take ? os : bsc; }
#pragma unroll
            for (int e = 0; e < 16; ++e) bs[e] = (16 * part + e == bi) ? -INFINITY : bs[e];
            idx[p] = bi; wv[p] = bsc; wsum += bsc; }
        const float scale = 2.5f / wsum;
#pragma unroll
        for (int p = 0; p < 8; ++p) { wv[p] *= scale;
            if ((p & 3) == part) { const int r_ = __hip_atomic_fetch_add(&cntl[idx[p]], 1, __ATOMIC_RELAXED, __HIP_MEMORY_SCOPE_WORKGROUP); if (p < 4) myrk0 = r_; else myrk1 = r_; } }
    }
    __syncthreads();
    if (tid < 64) basel[tid] = (int)__hip_atomic_fetch_add((unsigned*)(a.wsp() + WS_CTL) + CW_GCNT + l * 64 + tid, (unsigned)cntl[tid], __ATOMIC_RELAXED, __HIP_MEMORY_SCOPE_AGENT);
    __syncthreads();
    {
        const int tok = blk * 128 + tkl;
        int* ltk = (int*)(a.wsp() + WS_LTK); float* lw = (float*)(a.wsp() + WS_LW);
#pragma unroll
        for (int p = 0; p < 8; ++p) if ((p & 3) == part) { const int e = idx[p]; const size_t o = (size_t)e * LCAP + basel[e] + (p < 4 ? myrk0 : myrk1); ltk[o] = tok | (p << 16); lw[o] = wv[p]; }
    }
    __syncthreads();
}

typedef short bf16x8v __attribute__((ext_vector_type(8)));
__device__ __forceinline__ void moe_front(const ArgsV& a, int l, int blk, LAS unsigned char* lds, int tid, int wave, int lane) {
    { const bf16* wr = (const bf16*)(a.wsp() + WS_WR);
      v4u wt[16];
#pragma unroll
      for (int i = 0; i < 16; ++i) { const int idx = tid + 512 * i, row = idx >> 7, ch = idx & 127; wt[i] = *(const v4u*)(wr + (size_t)row * 1024 + ch * 8); }
#pragma unroll
      for (int i = 0; i < 16; ++i) { const int idx = tid + 512 * i, row = idx >> 7, ch = idx & 127; *(LAS v4u*)(lds + row * 2048 + ((ch ^ (row & 15)) * 16)) = wt[i]; } }
    { const int b = (blk * 128) >> 12; const float* mod = (const float*)(a.wsp() + WS_MOD); const float* sh = mod + (size_t)(l * 8 + b) * 6144 + 3072; const float* sc = sh + 1024; const float* gsrc = a.in[I_FFNG] + l * D;
      for (int c = tid; c < 1024; c += 512) { ((LAS float*)(lds + MF_GA))[c] = gsrc[c] * (sc[c] + 1.0f); ((LAS float*)(lds + MF_GB))[c] = sh[c]; } }
    norm_rows<1, false>(a, l, lds, blk * 8 + wave, lane);
    __syncthreads();
    const int fr = lane & 15, fq = lane >> 4;
    const bf16* arow = (const bf16*)a.outp() + (size_t)(blk * 128 + wave * 16 + fr) * XP + 8 * fq;
    const float rs_ = ((const LAS float*)(lds + MF_RSTD))[wave * 16 + fr];
    const LAS float* gAl = (const LAS float*)(lds + MF_GA) + 8 * fq; const LAS float* gBl = (const LAS float*)(lds + MF_GB) + 8 * fq;
    const LAS unsigned char* brow = lds + fr * 2048;
    pg8::f32x4 acc[4];
#pragma unroll
    for (int cb = 0; cb < 4; ++cb) acc[cb] = (pg8::f32x4){0.f, 0.f, 0.f, 0.f};
#pragma unroll 1
    for (int s0 = 0; s0 < 32; s0 += 8) { bf16x8v af[8]; v4u xr_[8];
#pragma unroll
        for (int s = 0; s < 8; ++s) xr_[s] = *(const v4u*)(arow + 32 * (s0 + s));
#pragma unroll
        for (int s = 0; s < 8; ++s) { const f32x4 ga0 = *(const LAS f32x4*)(gAl + 32 * (s0 + s)), ga1 = *(const LAS f32x4*)(gAl + 32 * (s0 + s) + 4), gb0 = *(const LAS f32x4*)(gBl + 32 * (s0 + s)), gb1 = *(const LAS f32x4*)(gBl + 32 * (s0 + s) + 4);
            const v4u w = xr_[s]; const f32x4 x0 = (f32x4){bflo(w.x), bfhi(w.x), bflo(w.y), bfhi(w.y)}, x1 = (f32x4){bflo(w.z), bfhi(w.z), bflo(w.w), bfhi(w.w)};
            const f32x4 h0 = x0 * rs_ * ga0 + gb0, h1 = x1 * rs_ * ga1 + gb1;
            v4u o; o.x = pk2(h0.x, h0.y); o.y = pk2(h0.z, h0.w); o.z = pk2(h1.x, h1.y); o.w = pk2(h1.z, h1.w); af[s] = __builtin_bit_cast(bf16x8v, o); }
#pragma unroll
        for (int s = 0; s < 8; ++s)
#pragma unroll
            for (int cb = 0; cb < 4; ++cb) { const bf16x8v bfr = *(const LAS bf16x8v*)(brow + cb * 16 * 2048 + (((4 * (s0 + s) + fq) ^ fr) * 16));
                acc[cb] = __builtin_amdgcn_mfma_f32_16x16x32_bf16(af[s], bfr, acc[cb], 0, 0, 0); } }
    __syncthreads();
    LAS float* lg = (LAS float*)lds;
#pragma unroll
    for (int cb = 0; cb < 4; ++cb)
#pragma unroll
        for (int r = 0; r < 4; ++r) lg[(wave * 16 + 4 * fq + r) * 65 + 16 * cb + fr] = acc[cb][r];
    __syncthreads();
    route_block(a, l, blk, lds, lg, tid);
}

constexpr int TAB_OFF = RING_BYTES + 1024, TAB_CNT = 0, TAB_TS = 80, TAB_TE = 160, TAB_TJ = 160 + MAXTILES;
static_assert(TAB_OFF + (TAB_TJ + MAXTILES) * 4 <= LDS_BYTES, "tile table fits above the ring");
__device__ __forceinline__ int moe_table(const ArgsV& a, int l, LAS unsigned char* lds, int tid) {
    LAS int* tab = (LAS int*)(lds + TAB_OFF);
    __syncthreads();
    if (tid < 64) {
        const int cnt = (int)((const unsigned*)(a.wsp() + WS_CTL))[CW_GCNT + l * 64 + tid]; tab[TAB_CNT + tid] = cnt;
        const int nt_ = (cnt + 255) >> 8; int inc = nt_;
#pragma unroll
        for (int o = 1; o < 64; o <<= 1) { const int v_ = __shfl_up(inc, o); if (tid >= o) inc += v_; }
        tab[TAB_TS + tid] = inc - nt_;
        if (tid == 63) { tab[TAB_TS + 64] = inc; tab[TAB_TS + 65] = inc + T / 256; tab[TAB_CNT + 64] = T; } }
    __syncthreads();
    const int ntl = tab[TAB_TS + 65];
    for (int t = tid; t < ntl; t += 512) { int e = 0;
        for (int q = 1; q < 65; ++q) e = (t >= tab[TAB_TS + q]) ? q : e;
        tab[TAB_TE + t] = e; tab[TAB_TJ + t] = t - tab[TAB_TS + e]; }
    __syncthreads();
    return ntl;
}

struct SchedDense { static constexpr bool EARLY_VOFF = false; pg8::TileOrder o; unsigned rowbytes; int pn_map;
    __device__ __forceinline__ bool next(int i, pg8::Unit& u) const { int pm, pn; if (!o.get(i, pm, pn)) return false; u.pm = pm; u.bt = pn; u.aux = 0;
        u.pn = pn_map == 0 ? pn : pn_map == 1 ? (pn < 4 ? pn : pn + 2) : (pn < 2 ? pn + 4 : pn + 8); return true; }
    __device__ __forceinline__ unsigned a_off(const pg8::Unit& u, int r) const { return (unsigned)(u.pm * 256 + r) * rowbytes; } };
struct SchedProj { static constexpr bool EARLY_VOFF = false; pg8::TileOrder o; unsigned rowbytes, delta;
    __device__ __forceinline__ bool next(int i, pg8::Unit& u) const { int pm, pn; if (!o.get(i >> 1, pm, pn)) return false; u.pm = pm; u.pn = pn; u.aux = i & 1; u.bt = (i & 1) * 4 + pn; return true; }
    __device__ __forceinline__ unsigned a_off(const pg8::Unit& u, int r) const { return (unsigned)u.aux * delta + (unsigned)(u.pm * 256 + r) * rowbytes; } };

struct EpiIn { static constexpr int NST = 16; static constexpr int ID = 0; static constexpr bool PREFETCH = false; static constexpr bool PERM = true;
    bf16* qkv; unsigned char* gates; const float* gains;
    __device__ __forceinline__ void operator()(const pg8::f32x4 (&acc)[2][2][4][2], const pg8::Unit& u, int wr, int wc, int fr, int fq) const {
        const int pn = u.pn, row0 = u.pm * 256 + wr * 64 + fr;
        if (pn < 12) {
            const int buf = pn >> 1, kind = buf % 3;
            bf16* out = qkv + (size_t)buf * QKV_STRIDE; const int colbase = 256 * (pn & 1) + 64 * wc + 8 * fq;
            const float* gp = gains + ((buf < 3 ? 0 : 2) + (kind & 1)) * 64;
            f32x4 gv[2][2];
#pragma unroll
            for (int bj = 0; bj < 2; ++bj)
#pragma unroll
                for (int n = 0; n < 2; ++n) gv[bj][n] = (kind < 2) ? *(const f32x4*)(gp + 32 * bj + 8 * fq + 4 * n) : (f32x4){1.f, 1.f, 1.f, 1.f};
#pragma unroll
            for (int ai = 0; ai < 2; ++ai)
#pragma unroll
                for (int m = 0; m < 4; ++m) { const int row = row0 + ai * 128 + m * 16; float rs = 1.0f;
                    if (kind < 2) { float ss = 0.f;
#pragma unroll
                        for (int bj = 0; bj < 2; ++bj)
#pragma unroll
                            for (int n = 0; n < 2; ++n) { const f32x4 x = acc[ai][bj][m][n]; ss += (x.x * x.x + x.y * x.y) + (x.z * x.z + x.w * x.w); }
                        ss += __shfl_xor(ss, 16); ss += __shfl_xor(ss, 32);
                        rs = __builtin_amdgcn_rsqf(ss * (1.0f / 64.0f) + EPS * (WGU_SCALE * WGU_SCALE)); if (kind == 0) rs *= C2; }
                    else rs = 1.0f / WGU_SCALE;
#pragma unroll
                    for (int bj = 0; bj < 2; ++bj) { const f32x4 v0 = acc[ai][bj][m][0] * rs * gv[bj][0], v1 = acc[ai][bj][m][1] * rs * gv[bj][1];
                        v4u w; w.x = pg8::cvt_pk_bf16(v0.x, v0.y); w.y = pg8::cvt_pk_bf16(v0.z, v0.w); w.z = pg8::cvt_pk_bf16(v1.x, v1.y); w.w = pg8::cvt_pk_bf16(v1.z, v1.w);
                        *(v4u*)(out + (size_t)row * 512 + colbase + 32 * bj) = w; } }
        } else {
            unsigned char* out = gates + (size_t)((pn - 12) >> 2) * G_STRIDE; const int colbase = 256 * ((pn - 12) & 3) + 64 * wc + 8 * fq;
#pragma unroll
            for (int ai = 0; ai < 2; ++ai)
#pragma unroll
                for (int m = 0; m < 4; ++m) { const int row = row0 + ai * 128 + m * 16;
#pragma unroll
                    for (int bj = 0; bj < 2; ++bj) { const f32x4 a0 = acc[ai][bj][m][0], a1 = acc[ai][bj][m][1];
#define sigmoidf_(x) __builtin_amdgcn_rcpf((1.0f / 255.0f) + __builtin_amdgcn_exp2f(__builtin_fmaf((x), -1.4426950408889634f / WGU_SCALE, -7.994353436858858f)))
                        unsigned q0 = __builtin_amdgcn_cvt_pk_u8_f32(sigmoidf_(a0.x), 0, 0u); q0 = __builtin_amdgcn_cvt_pk_u8_f32(sigmoidf_(a0.y), 1, q0); q0 = __builtin_amdgcn_cvt_pk_u8_f32(sigmoidf_(a0.z), 2, q0); q0 = __builtin_amdgcn_cvt_pk_u8_f32(sigmoidf_(a0.w), 3, q0);
                        unsigned q1 = __builtin_amdgcn_cvt_pk_u8_f32(sigmoidf_(a1.x), 0, 0u); q1 = __builtin_amdgcn_cvt_pk_u8_f32(sigmoidf_(a1.y), 1, q1); q1 = __builtin_amdgcn_cvt_pk_u8_f32(sigmoidf_(a1.z), 2, q1); q1 = __builtin_amdgcn_cvt_pk_u8_f32(sigmoidf_(a1.w), 3, q1);
#undef sigmoidf_
                        v2u w; w.x = q0; w.y = q1; *(v2u*)(out + (size_t)row * 1024 + colbase + 32 * bj) = w; } }
        }
    } };
#define U8F(w, k) ((float)(((w) >> (8 * (k))) & 0xffu))
struct EpiProj { static constexpr int NST = 16; static constexpr int ID = 1; static constexpr bool PREFETCH = false; static constexpr bool PERM = true;
    const unsigned char* gates; unsigned char* M; unsigned char* MQ;
    __device__ __forceinline__ void operator()(pg8::f32x4 (&acc)[2][2][4][2], const pg8::Unit& u, int wr, int wc, int fr, int fq) const {
        const int pass = u.aux; const unsigned char* g = gates + (size_t)pass * G_STRIDE; const int col0 = u.pn * 256 + wc * 32 + 8 * fq;
        const size_t row0 = (size_t)(u.pm * 256 + wr * 64 + fr) * 1024 + col0;
        if (pass == 0) {
            v2u ga[8][2];
#pragma unroll
            for (int gi = 0; gi < 8; ++gi)
#pragma unroll
                for (int bj = 0; bj < 2; ++bj) ga[gi][bj] = *(const v2u*)(g + row0 + (size_t)((gi >> 2) * 128 + (gi & 3) * 16) * 1024 + bj * 128);
#pragma unroll
            for (int gi = 0; gi < 8; ++gi) { const int ai = gi >> 2, m = gi & 3; const size_t ro = row0 + (size_t)(ai * 128 + m * 16) * 1024;
#pragma unroll
                for (int bj = 0; bj < 2; ++bj) { const v2u gw_ = ga[gi][bj]; const f32x4 a0 = acc[ai][bj][m][0] * (M_SCALE / 255.0f), a1 = acc[ai][bj][m][1] * (M_SCALE / 255.0f);
                    const float c0 = __builtin_amdgcn_fmed3f(U8F(gw_.x, 0) * a0.x, -440.f, 440.f), c1 = __builtin_amdgcn_fmed3f(U8F(gw_.x, 1) * a0.y, -440.f, 440.f), c2 = __builtin_amdgcn_fmed3f(U8F(gw_.x, 2) * a0.z, -440.f, 440.f), c3 = __builtin_amdgcn_fmed3f(U8F(gw_.x, 3) * a0.w, -440.f, 440.f),
                                c4 = __builtin_amdgcn_fmed3f(U8F(gw_.y, 0) * a1.x, -440.f, 440.f), c5 = __builtin_amdgcn_fmed3f(U8F(gw_.y, 1) * a1.y, -440.f, 440.f), c6 = __builtin_amdgcn_fmed3f(U8F(gw_.y, 2) * a1.z, -440.f, 440.f), c7 = __builtin_amdgcn_fmed3f(U8F(gw_.y, 3) * a1.w, -440.f, 440.f);
                    int q0 = __builtin_amdgcn_cvt_pk_fp8_f32(c0, c1, 0, false); q0 = __builtin_amdgcn_cvt_pk_fp8_f32(c2, c3, q0, true); int q1 = __builtin_amdgcn_cvt_pk_fp8_f32(c4, c5, 0, false); q1 = __builtin_amdgcn_cvt_pk_fp8_f32(c6, c7, q1, true);
                    v2u w; w.x = (unsigned)q0; w.y = (unsigned)q1; *(v2u*)(M + ro + bj * 128) = w; } }
            return; }
        v2u gb[8][2], mb[8][2];
#define EPROJ_LOAD(gi, buf) do { const size_t ro_ = row0 + (size_t)(((gi) >> 2) * 128 + ((gi) & 3) * 16) * 1024; _Pragma("unroll") for (int bj = 0; bj < 2; ++bj) { gb[buf][bj] = *(const v2u*)(g + ro_ + bj * 128); \
            mb[buf][bj] = *(const v2u*)(M + ro_ + bj * 128); } } while (0)
#pragma unroll
        for (int gi = 0; gi < 8; ++gi) EPROJ_LOAD(gi, gi);
#pragma unroll
        for (int gi = 0; gi < 8; ++gi) { const int ai = gi >> 2, m = gi & 3, cb = gi;
            const size_t ro = row0 + (size_t)(ai * 128 + m * 16) * 1024;
#pragma unroll
            for (int bj = 0; bj < 2; ++bj) { const v2u gw_ = gb[cb][bj]; const v2u p = mb[cb][bj]; const f32x4 a0 = acc[ai][bj][m][0] * (M_SCALE / 255.0f), a1 = acc[ai][bj][m][1] * (M_SCALE / 255.0f);
                const f32x2_ p01 = __builtin_amdgcn_cvt_pk_f32_fp8((int)p.x, false), p23 = __builtin_amdgcn_cvt_pk_f32_fp8((int)p.x, true), p45 = __builtin_amdgcn_cvt_pk_f32_fp8((int)p.y, false), p67 = __builtin_amdgcn_cvt_pk_f32_fp8((int)p.y, true);
                const float r0 = U8F(gw_.x, 0) * a0.x + p01.x, r1 = U8F(gw_.x, 1) * a0.y + p01.y, r2 = U8F(gw_.x, 2) * a0.z + p23.x, r3 = U8F(gw_.x, 3) * a0.w + p23.y,
                            r4 = U8F(gw_.y, 0) * a1.x + p45.x, r5 = U8F(gw_.y, 1) * a1.y + p45.y, r6 = U8F(gw_.y, 2) * a1.z + p67.x, r7 = U8F(gw_.y, 3) * a1.w + p67.y;
                const float c0 = __builtin_amdgcn_fmed3f(r0, -440.f, 440.f), c1 = __builtin_amdgcn_fmed3f(r1, -440.f, 440.f), c2 = __builtin_amdgcn_fmed3f(r2, -440.f, 440.f), c3 = __builtin_amdgcn_fmed3f(r3, -440.f, 440.f),
                            c4 = __builtin_amdgcn_fmed3f(r4, -440.f, 440.f), c5 = __builtin_amdgcn_fmed3f(r5, -440.f, 440.f), c6 = __builtin_amdgcn_fmed3f(r6, -440.f, 440.f), c7 = __builtin_amdgcn_fmed3f(r7, -440.f, 440.f);
                int q0 = __builtin_amdgcn_cvt_pk_fp8_f32(c0, c1, 0, false); q0 = __builtin_amdgcn_cvt_pk_fp8_f32(c2, c3, q0, true); int q1 = __builtin_amdgcn_cvt_pk_fp8_f32(c4, c5, 0, false); q1 = __builtin_amdgcn_cvt_pk_fp8_f32(c6, c7, q1, true);
                v2u w; w.x = (unsigned)q0; w.y = (unsigned)q1; *(v2u*)(MQ + ro + bj * 128) = w; } }
#undef EPROJ_LOAD
    } };
struct EpiOut { static constexpr int NST = 16; static constexpr int ID = 2; static constexpr bool PREFETCH = false; static constexpr bool PERM = true;
    const float* xin32; bf16* xb; const float* g1; bool in32;
    __device__ __forceinline__ void operator()(const pg8::f32x4 (&acc)[2][2][4][2], const pg8::Unit& u, int wr, int wc, int fr, int fq) const {
        const int b = (u.pm * 256) >> 12, col0 = u.pn * 256 + wc * 32 + 8 * fq;
        f32x4 gv[2][2];
#pragma unroll
        for (int bj = 0; bj < 2; ++bj)
#pragma unroll
            for (int n = 0; n < 2; ++n) gv[bj][n] = *(const f32x4*)(g1 + (size_t)b * 6144 + col0 + bj * 128 + n * 4) * (1.0f / (M_SCALE * WGU_SCALE));
        const size_t rowi = (size_t)(u.pm * 256 + wr * 64 + fr);
#define EOUT_ROW(gi) (rowi + (size_t)(((gi) >> 2) * 128 + ((gi) & 3) * 16))
#define EOUT_STORE(gi, X0, X1, bj) do { const f32x4 r0_ = (X0) + gv[bj][0] * acc[(gi) >> 2][bj][(gi) & 3][0], r1_ = (X1) + gv[bj][1] * acc[(gi) >> 2][bj][(gi) & 3][1]; \
            v4u w_; w_.x = pg8::cvt_pk_bf16(r0_.x, r0_.y); w_.y = pg8::cvt_pk_bf16(r0_.z, r0_.w); w_.z = pg8::cvt_pk_bf16(r1_.x, r1_.y); w_.w = pg8::cvt_pk_bf16(r1_.z, r1_.w); *(v4u*)(xb + EOUT_ROW(gi) * XP + col0 + (bj) * 128) = w_; } while (0)
        if (in32) {
            f32x4 xf[2][2][2];
#define EOUT_LOAD(gi, buf) do { _Pragma("unroll") for (int bj = 0; bj < 2; ++bj) _Pragma("unroll") for (int n = 0; n < 2; ++n) xf[buf][bj][n] = *(const f32x4*)(xin32 + EOUT_ROW(gi) * 1024 + col0 + bj * 128 + n * 4); } while (0)
#pragma unroll
            for (int hb = 0; hb < 4; ++hb) {
#pragma unroll
            for (int g2 = 0; g2 < 2; ++g2) EOUT_LOAD(2 * hb + g2, g2);
#pragma unroll
            for (int g2 = 0; g2 < 2; ++g2) { const int gi = 2 * hb + g2, cb = g2;
#pragma unroll
                for (int bj = 0; bj < 2; ++bj) EOUT_STORE(gi, xf[cb][bj][0], xf[cb][bj][1], bj); }
            asm volatile("" ::: "memory"); }
#undef EOUT_LOAD
        } else {
            v4u xq[8][2];
#define EOUT_LOAD(gi, buf) do { _Pragma("unroll") for (int bj = 0; bj < 2; ++bj) xq[buf][bj] = *(const v4u*)(xb + EOUT_ROW(gi) * XP + col0 + bj * 128); } while (0)
#pragma unroll
            for (int gi = 0; gi < 8; ++gi) EOUT_LOAD(gi, gi);
#pragma unroll
            for (int gi = 0; gi < 8; ++gi) { const int cb = gi;
#pragma unroll
                for (int bj = 0; bj < 2; ++bj) { const v4u q_ = xq[cb][bj];
                    const f32x4 x0 = (f32x4){bflo(q_.x), bfhi(q_.x), bflo(q_.y), bfhi(q_.y)}, x1 = (f32x4){bflo(q_.z), bfhi(q_.z), bflo(q_.w), bfhi(q_.w)};
                    EOUT_STORE(gi, x0, x1, bj); } }
#undef EOUT_LOAD
        }
#undef EOUT_STORE
#undef EOUT_ROW
    } };
struct EpiRouter { static constexpr int NST = 0; static constexpr int ID = 5; static constexpr bool PERM = false;
    float* logits;
    __device__ __forceinline__ void operator()(const pg8::f32x4 (&acc)[2][2][4][2], const pg8::Unit& u, int wr, int wc, int fr, int fq) const {
        if (wc < 2) {
#pragma unroll
            for (int ai = 0; ai < 2; ++ai)
#pragma unroll
                for (int m = 0; m < 4; ++m)
#pragma unroll
                    for (int n = 0; n < 2; ++n) *(f32x4*)(logits + (size_t)(u.pm * 256 + ai * 128 + wr * 64 + m * 16 + fr) * 64 + wc * 32 + n * 16 + 4 * fq) = acc[ai][0][m][n]; }
    } };
struct EpiGU { static constexpr int NST = 8; static constexpr int ID = 3; static constexpr bool PREFETCH = false; static constexpr bool PERM = true;
    unsigned char* act;
    __device__ __forceinline__ void operator()(pg8::f32x4 (&acc)[2][2][4][2], const pg8::Unit& u, int wr, int wc, int fr, int fq) const {
        const int col0 = u.pn * 128 + wc * 32 + 8 * fq;
#pragma unroll
        for (int ai = 0; ai < 2; ++ai)
#pragma unroll
            for (int m = 0; m < 4; ++m) { const size_t row = (size_t)(u.pm * 256 + ai * 128 + wr * 64 + m * 16 + fr);
                float av[8];
#pragma unroll
                for (int n = 0; n < 2; ++n)
#pragma unroll
                    for (int i = 0; i < 4; ++i) { const float g_ = acc[ai][0][m][n][i], u_ = acc[ai][1][m][n][i];
                        const float sg = __builtin_amdgcn_rcpf((WGU_SCALE * WGU_SCALE / ACT_SCALE) + __builtin_amdgcn_exp2f(__builtin_fmaf(g_, -1.4426950408889634f / WGU_SCALE, 9.0f)));
                        av[4 * n + i] = __builtin_amdgcn_fmed3f((g_ * u_) * sg, -440.0f, 440.0f); }
                int q0 = __builtin_amdgcn_cvt_pk_fp8_f32(av[0], av[1], 0, false); q0 = __builtin_amdgcn_cvt_pk_fp8_f32(av[2], av[3], q0, true);
                int q1 = __builtin_amdgcn_cvt_pk_fp8_f32(av[4], av[5], 0, false); q1 = __builtin_amdgcn_cvt_pk_fp8_f32(av[6], av[7], q1, true);
                v2u w; w.x = (unsigned)q0; w.y = (unsigned)q1; *(v2u*)(act + row * 256 + col0) = w; }
    } };
template <bool GATHER> struct SchedMoe { static constexpr bool EARLY_VOFF = GATHER;
    const LAS int* tab; const int* ltk; int nunits, G, c, npn_log2; unsigned rowbytes;
    __device__ __forceinline__ bool next(int i, pg8::Unit& u) const { const int L = i * G + c; if (L >= nunits) return false; const int rt = L >> npn_log2, pn = L & ((1 << npn_log2) - 1); const int e = tab[TAB_TE + rt];
        u.pm = rt; u.pn = pn; u.bt = (e << npn_log2) + pn; u.aux = e | (tab[TAB_TJ + rt] << 8); return true; }
    __device__ __forceinline__ unsigned a_off(const pg8::Unit& u, int r) const {
        if (!GATHER) return (unsigned)(u.pm * 256 + r) * rowbytes;
        return a_fin(u, r, a_raw(u, r)); }
    __device__ __forceinline__ int a_raw(const pg8::Unit& u, int r) const { const int e = u.aux & 0xff, pos = (u.aux >> 8) * 256 + r; return ltk[(size_t)(e & 63) * LCAP + (pos & (LCAP - 1))]; }
    __device__ __forceinline__ unsigned a_fin(const pg8::Unit& u, int r, int raw) const { const int e = u.aux & 0xff, pos = (u.aux >> 8) * 256 + r;
        int tok = T;
        if (e == 64) tok = pos; else if (pos < tab[TAB_CNT + e]) tok = raw & 0xffff;
        return (unsigned)tok * rowbytes; } };
constexpr int TAB_PF = TAB_TJ + MAXTILES;
static_assert(TAB_OFF + (TAB_PF + 2 * 512) * 4 <= LDS_BYTES, "epilogue side table fits");
struct EpiDown { static constexpr int NST = 0; static constexpr int ID = 4; static constexpr bool PREFETCH = true; static constexpr bool PERM = true;
    unsigned char* slots; const float* lw; const int* ltk; LAS int* tab;
    __device__ __forceinline__ void fetch(const pg8::Unit& u, int tid, float& w, int& d) const {
        if (tid < 256) { const int e = u.aux & 0xff, pos = (u.aux >> 8) * 256 + tid; w = SLOT_SCALE / (WGU_SCALE * ACT_SCALE); d = pos * NSLOT + 8;
            if (e < 64) { if (pos < tab[TAB_CNT + e]) { const int tk = ltk[(size_t)e * LCAP + pos]; w = lw[(size_t)e * LCAP + pos] * (SLOT_SCALE / (WGU_SCALE * ACT_SCALE)); d = (tk & 0xffff) * NSLOT + (tk >> 16); } else d = -1; } } }
    __device__ __forceinline__ void stash(int par, int tid, float w, int d) const { if (tid < 256) { tab[TAB_PF + par * 512 + tid] = __float_as_int(w); tab[TAB_PF + par * 512 + 256 + tid] = d; } }
    __device__ __forceinline__ void operator()(pg8::f32x4 (&acc)[2][2][4][2], const pg8::Unit& u, int wr, int wc, int fr, int fq, int par) const {
        const int col0 = u.pn * 256 + wc * 64 + 16 * fq;
        float wv[8]; int dv[8];
#pragma unroll
        for (int gi = 0; gi < 8; ++gi) { const int rl = (gi >> 2) * 128 + wr * 64 + (gi & 3) * 16 + fr; wv[gi] = __int_as_float(tab[TAB_PF + par * 512 + rl]); dv[gi] = tab[TAB_PF + par * 512 + 256 + rl]; }
#pragma unroll
        for (int gi = 0; gi < 8; ++gi) { const int ai = gi >> 2, m = gi & 3; const float w = wv[gi]; const int dst = dv[gi];
            if (dst >= 0) { v4u o;
#pragma unroll
                for (int bj = 0; bj < 2; ++bj) { f32x4 a0 = acc[ai][bj][m][0] * w, a1 = acc[ai][bj][m][1] * w;
#pragma unroll
                    for (int i = 0; i < 4; ++i) { a0[i] = __builtin_amdgcn_fmed3f(a0[i], -440.0f, 440.0f); a1[i] = __builtin_amdgcn_fmed3f(a1[i], -440.0f, 440.0f); }
                    int q0 = __builtin_amdgcn_cvt_pk_fp8_f32(a0.x, a0.y, 0, false); q0 = __builtin_amdgcn_cvt_pk_fp8_f32(a0.z, a0.w, q0, true);
                    int q1 = __builtin_amdgcn_cvt_pk_fp8_f32(a1.x, a1.y, 0, false); q1 = __builtin_amdgcn_cvt_pk_fp8_f32(a1.z, a1.w, q1, true);
                    if (bj == 0) { o.x = (unsigned)q0; o.y = (unsigned)q1; } else { o.z = (unsigned)q0; o.w = (unsigned)q1; } }
                *(v4u*)(slots + (size_t)dst * 1024 + col0) = o; } }
    } };
#ifndef PH_MASK
#define PH_MASK 0xffffffffu
#endif
#define PH(k) ((PH_MASK >> (k)) & 1u)
#ifdef PROBE
#define STAMP(idx) do { if (blockIdx.x == 0 && threadIdx.x == 0) ((unsigned long long*)(args.wsp() + WS_META))[(idx)] = __builtin_amdgcn_s_memrealtime(); } while (0)
#else
#define STAMP(idx) do {} while (0)
#endif
__global__ void __launch_bounds__(NWAVES * 64, 2) mk_fwd(Args args_unused) {
    const ArgsV args{};
    extern __shared__ __attribute__((aligned(16))) unsigned char lds_raw[];
    LAS unsigned char* lds = (LAS unsigned char*)lds_raw;
    volatile LAS unsigned* MISC = (volatile LAS unsigned*)(lds + MISC_OFF);
    const int G = gridDim.x, bx = blockIdx.x;
    const int vcu = (G % 8 == 0) ? (bx % 8) * (G / 8) + bx / 8 : bx;
    for (int u = threadIdx.x; u < (LDS_BYTES - LDSCTL_OFF) / 4; u += NWAVES * 64) ((LAS unsigned*)(lds + LDSCTL_OFF))[u] = 0u;
    __syncthreads();
    const unsigned bar_x = (unsigned)__builtin_amdgcn_readfirstlane((int)xcd_barrier_post((unsigned*)(args.wsp() + WS_CTL) + CW_BAR, MISC + 8).x);
#define xcd_barrier(dummy) do { XcdBarrier b_; b_.bar = (unsigned*)(args.wsp() + WS_CTL) + CW_BAR; { unsigned x_ = bar_x; asm volatile("" : "+s"(x_)); b_.x = x_; } b_.st = (volatile LAS unsigned*)(lds + MISC_OFF) + 8; (xcd_barrier)(b_); } while (0)
    const int NGW = G * NWAVES;
#define PHASE_IDS int tid = threadIdx.x; asm volatile("" : "+v"(tid)); const int lane = tid & 63; const int wave = __builtin_amdgcn_readfirstlane(tid >> 6); const int gw = vcu * NWAVES + wave; (void)lane; (void)gw;
#define Hb ((bf16*)(args.wsp() + WS_H))
#define H2b ((bf16*)(args.wsp() + WS_H2))
#define QKVb ((bf16*)(args.wsp() + WS_QKV))
#define Gb ((unsigned char*)(args.wsp() + WS_G))
#define MODb ((float*)(args.wsp() + WS_MOD))

    STAMP(40);
#ifdef PROBE
    if (blockIdx.x == 0 && threadIdx.x == 0) { for (int i = 64; i < 96; ++i) ((unsigned long long*)(args.wsp() + WS_META))[i] = 0ull; }
#endif
    { PHASE_IDS
    if (PH(0)) { for (int u = bx; u < 192; u += G) mod_unit(args, u, lds, tid, wave, lane); }
    if (PH(1)) convert_weights(args, 0, lds, gw, NGW, wave, lane); }
    xcd_barrier(bar);
    STAMP(41);

    for (int l = 0; l < DEPTH; ++l) {
        STAMP(l * 16 + 0);
        { PHASE_IDS
        if (PH(1) && l == 1) convert_weights(args, 1, lds, gw, NGW, wave, lane);
        if (PH(2)) { LAS float* wfl = (LAS float*)(lds + 73728); const float* wsrc = args.in[I_WIN] + (size_t)l * D * NIN + 3072;
          for (int k = tid; k < 1024; k += 512) { const f32x4 w0 = *(const f32x4*)(wsrc + (size_t)k * NIN), w1 = *(const f32x4*)(wsrc + (size_t)k * NIN + 4);
              wfl[0 * 1024 + k] = w0.x; wfl[1 * 1024 + k] = w0.y; wfl[2 * 1024 + k] = w0.z; wfl[3 * 1024 + k] = w0.w; wfl[4 * 1024 + k] = w1.x; wfl[5 * 1024 + k] = w1.y; wfl[6 * 1024 + k] = w1.z; wfl[7 * 1024 + k] = w1.w; }
          if (bx == 0 && wave < 4) ((float*)(args.wsp() + WS_GAIN))[wave * 64 + lane] = args.in[I_QNA + wave][l * 64 + lane];
          __syncthreads();
          if (l == 0) { for (int g = gw; g < T / 16; g += NGW) norm_rows<0, false>(args, l, lds, g, lane); }
          else { for (int g = gw; g < T / 16; g += NGW) norm_rows<0, true>(args, l, lds, g, lane); }
          __syncthreads(); } }
        xcd_barrier(bar);
        STAMP(l * 16 + 1);

        if (PH(3)) for (int s = bx; s < 64; s += G) { PHASE_IDS
            const float* lf = (const float*)(args.wsp() + WS_LOGF) + (size_t)s * SEQ; float* cm = (float*)(args.wsp() + WS_CUM) + (size_t)s * SEQ;
            LAS float* wtot = (LAS float*)lds;
            const f32x4 a0 = *(const f32x4*)(lf + 8 * tid), a1 = *(const f32x4*)(lf + 8 * tid + 4);
            float v[8]; v[0] = a0.x; v[1] = v[0] + a0.y; v[2] = v[1] + a0.z; v[3] = v[2] + a0.w; v[4] = v[3] + a1.x; v[5] = v[4] + a1.y; v[6] = v[5] + a1.z; v[7] = v[6] + a1.w;
            float inc = v[7];
#pragma unroll
            for (int o = 1; o < 64; o <<= 1) { const float t = __shfl_up(inc, o); if (lane >= o) inc += t; }
            if (lane == 63) wtot[wave] = inc;
            __syncthreads();
            float base = inc - v[7];
            for (int w = 0; w < wave; ++w) base += wtot[w];
            *(f32x4*)(cm + 8 * tid) = (f32x4){v[0] + base, v[1] + base, v[2] + base, v[3] + base};
            *(f32x4*)(cm + 8 * tid + 4) = (f32x4){v[4] + base, v[5] + base, v[6] + base, v[7] + base};
            __syncthreads();
        }
        if (PH(4)) { EpiIn E{QKVb, Gb, (const float*)(args.wsp() + WS_GAIN)};
#ifdef STAG_PB
          { const unsigned long long t0_ = __builtin_amdgcn_s_memrealtime(); const unsigned long long d_ = (unsigned long long)((bx >> 3) & 7) * STAG_PB;
            while (__builtin_amdgcn_s_memrealtime() - t0_ < d_) __builtin_amdgcn_s_sleep(4); }
#endif
          { SchedDense S; S.o.init(T / 256, 20, G, bx); S.rowbytes = 1024; S.pn_map = 0;
            pg8::gemm_phase<EpiIn, SchedDense, true>(lds, args.wsp() + WS_HQ, (const bf16*)(args.wsp() + WS_WING), 512, S, E); } }
        xcd_barrier(bar);
        STAMP(l * 16 + 2);

        if (PH(5)) for (int v = vcu; v < 256; v += G) {
            const int bh = v >> 2, s = v & 3, b = bh >> 3, h = bh & 7;
            const float* cum = (const float*)(args.wsp() + WS_CUM); const float* rel = args.in[I_REL] + (size_t)l * 8 * 257;
            __syncthreads(); fox::prep_kaug(cum + (size_t)bh * SEQ, (char*)lds_raw); __syncthreads();
            for (int i = 0; i < 4; ++i) { const int qb = (i == 0) ? s : (i == 1) ? 7 - s : (i == 2) ? 8 + s : 15 - s;
                fox::attn_unit<8>(b, h, qb, (const fox::bf16*)(QKVb + 3 * QKV_STRIDE), (const fox::bf16*)(QKVb + 4 * QKV_STRIDE), (const fox::bf16*)(QKVb + 5 * QKV_STRIDE), (fox::bf16*)(QKVb + 3 * QKV_STRIDE), cum + (size_t)bh * SEQ, (char*)lds_raw); }
            for (int i = 0; i < 4; ++i) att::attn_unit<1>(b, h, 4 * s + i, QKVb, QKVb + 1 * QKV_STRIDE, QKVb + 2 * QKV_STRIDE, QKVb, cum, rel, lds);
        }
        __syncthreads();
        xcd_barrier(bar);
        STAMP(l * 16 + 3);

        if (PH(6)) { SchedProj S; S.o.init(T / 256, 4, G, bx); S.rowbytes = 1024; S.delta = (unsigned)(3 * QKV_STRIDE * 2);
          EpiProj E{Gb, (unsigned char*)(args.wsp() + WS_H), (unsigned char*)(args.wsp() + WS_MQ)};
          pg8::gemm_phase<EpiProj, SchedProj>(lds, QKVb, (const bf16*)(args.wsp() + WS_WPROJ), 512, S, E); }
        xcd_barrier(bar);
        STAMP(l * 16 + 4);

        if (PH(7)) { SchedDense S; S.o.init(T / 256, 4, G, bx); S.rowbytes = 1024; S.pn_map = 0;
          EpiOut E{args.in[I_X], (bf16*)args.outp(), MODb + (size_t)l * 8 * 6144 + 2048, l == 0};
          pg8::gemm_phase<EpiOut, SchedDense, true>(lds, args.wsp() + WS_MQ, (const bf16*)(args.wsp() + WS_WOUT), 512, S, E); }
        xcd_barrier(bar);
        STAMP(l * 16 + 5);

        if (PH(8)) for (int blk = vcu; blk < 256; blk += G) { PHASE_IDS moe_front(args, l, blk, lds, tid, wave, lane); }
        if (bx == 0) { PHASE_IDS if (tid < 256) ((unsigned*)(args.wsp() + WS_H2Q + (size_t)T * D))[tid] = 0u; }
        xcd_barrier(bar);
        STAMP(l * 16 + 6); STAMP(l * 16 + 7); STAMP(l * 16 + 8); STAMP(l * 16 + 9);

        {   int ntl; { PHASE_IDS ntl = moe_table(args, l, lds, tid); }
            LAS int* tab = (LAS int*)(lds + TAB_OFF);
            if (PH(13)) { SchedMoe<true> S{tab, (const int*)(args.wsp() + WS_LTK), ntl * 2, G, vcu, 1, 1024u};
              EpiGU E{(unsigned char*)(args.wsp() + WS_ACT)};
              pg8::gemm_phase<EpiGU, SchedMoe<true>, true>(lds, args.wsp() + WS_H2Q, (const bf16*)(args.wsp() + WS_WGU), 512, S, E); }
            xcd_barrier(bar);
            STAMP(l * 16 + 10);
            if (PH(14)) { SchedMoe<false> S{tab, nullptr, ntl * 4, G, vcu, 2, 256u};
              EpiDown E{(unsigned char*)(args.wsp() + WS_SLOT), (const float*)(args.wsp() + WS_LW), (const int*)(args.wsp() + WS_LTK), tab};
              int kdn = 128; asm volatile("" : "+s"(kdn));
              pg8::gemm_phase<EpiDown, SchedMoe<false>, true>(lds, args.wsp() + WS_ACT, (const bf16*)(args.wsp() + WS_WD), kdn, S, E); }
            xcd_barrier(bar);
            STAMP(l * 16 + 11);
            STAMP(l * 16 + 12);
            STAMP(l * 16 + 13);
        }
    }
    if (PH(12)) { PHASE_IDS reduce_rows(args, DEPTH - 1, 0, T, gw, NGW, lane); }
#ifdef PROBE
    if (blockIdx.x == 0 && threadIdx.x == 0) {
        const unsigned long long* ts = (const unsigned long long*)(args.wsp() + WS_META);
        const unsigned long long tend = __builtin_amdgcn_s_memrealtime();
        unsigned long long dA = 0, dB = 0;
        if (PROBE_A0 == 99) dA = 0; else if (PROBE_A0 == 50) dA = tend - ts[29]; else if (PROBE_A0 >= 40) dA = ts[PROBE_A1] - ts[PROBE_A0]; else for (int l = 0; l < DEPTH; ++l) dA += ts[l * 16 + PROBE_A1] - ts[l * 16 + PROBE_A0];
        if (PROBE_B0 >= 60) dB = ts[64 + (PROBE_B0 - 60) * 4 + PROBE_B1]; else if (PROBE_B0 == 50) dB = tend - ts[29]; else if (PROBE_B0 >= 40) dB = ts[PROBE_B1] - ts[PROBE_B0]; else for (int l = 0; l < DEPTH; ++l) dB += ts[l * 16 + PROBE_B1] - ts[l * 16 + PROBE_B0];
        asm volatile("s_waitcnt vmcnt(0)" ::: "memory");
        args.outp()[0] = 8.0f + ((float)dB * 0.01f - (PROBE_A0 == 99 ? (float)PROBE_A1 : 0.f)) * (1.0f / PROBE_BSCALE);
        while (__builtin_amdgcn_s_memrealtime() - tend < dA) __builtin_amdgcn_s_sleep(8);
    }
#endif
}

#undef xcd_barrier
#undef Hb
#undef H2b
#undef QKVb
#undef Gb
#undef MODb
extern "C" void kernel_launch(void* const* d_in, const int* in_sizes, int n_in, void* d_out, int out_size, void* d_ws, size_t ws_size, hipStream_t stream) {
    static int grid = 0;
    if (grid == 0) {
        if (n_in != 24 || out_size != T * D || ws_size < WS_END) { fprintf(stderr, "kernel_launch: unexpected shapes (n_in %d, out %d, ws %zu)\n", n_in, out_size, ws_size); grid = -1; return; }
        int dev = 0, cus = 0, per_cu = 0;
        if (hipGetDevice(&dev) != hipSuccess || hipDeviceGetAttribute(&cus, hipDeviceAttributeMultiprocessorCount, dev) != hipSuccess) { grid = -1; return; }
        if (hipFuncSetAttribute((const void*)mk_fwd, hipFuncAttributeMaxDynamicSharedMemorySize, LDS_BYTES) != hipSuccess) { fprintf(stderr, "kernel_launch: hipFuncSetAttribute failed\n"); grid = -1; return; }
        if (hipOccupancyMaxActiveBlocksPerMultiprocessor(&per_cu, (const void*)mk_fwd, NWAVES * 64, LDS_BYTES) != hipSuccess || per_cu < 1) fprintf(stderr, "kernel_launch: occupancy query reports %d\n", per_cu);
        (void)hipGetLastError();
        grid = cus;
    }
    if (grid < 0) return;
    if (hipMemsetAsync((char*)d_ws + WS_CTL, 0, CTL_ZERO_BYTES, stream) != hipSuccess) return;
    Args a{};
    for (int i = 0; i < 24; ++i) a.in[i] = (const float*)d_in[i];
    a.out = (float*)d_out; a.ws = (unsigned char*)d_ws;
    hipLaunchKernelGGL(mk_fwd, dim3(grid), dim3(NWAVES * 64), LDS_BYTES, stream, a);
}
```

```cpp
#include <hip/hip_runtime.h>
#include <hip/hip_bf16.h>
#include <cstdio>
#include <cstdint>
#include <cmath>
namespace pg8 {
#define PG8_LAS __attribute__((address_space(3)))
typedef unsigned short bf16_t;
typedef short bf16x8 __attribute__((ext_vector_type(8)));
typedef float f32x4 __attribute__((ext_vector_type(4)));
typedef float f32x2 __attribute__((ext_vector_type(2)));
typedef unsigned u32x4 __attribute__((ext_vector_type(4)));
constexpr int BM = 256, BK = 64, HALF = 128, HTB = HALF * BK * 2  , STAGE_BYTES = 8 * HTB, NXCD = 8, WGM = 8;

__host__ __device__ __forceinline__ int lds_byte(int r, int c) { const int st = (r >> 4) * 2 + (c >> 5), rr = r & 15, cc = c & 31, ob = rr * 64 + cc * 2; return st * 1024 + (ob ^ (((ob >> 9) & 1) << 5)); }
__host__ __device__ __forceinline__ void stage_rc(int b, int& R, int& C) { const int st = b / 1024, sb = b % 1024, swz = sb ^ (((sb >> 9) & 1) << 5); R = (st >> 1) * 16 + swz / 64; C = (st & 1) * 32 + (swz % 64) / 2; }
__host__ __device__ __forceinline__ int perm32(int rho) { const int n = rho >> 4, i = rho & 15; return 8 * (i >> 2) + 4 * n + (i & 3); }

struct Unit { int pm, pn, bt, aux; };

struct TileOrder {
    int nM, nN, nwg, G, c;
    __device__ __forceinline__ void init(int nM_, int nN_, int G_, int c_) { nM = nM_; nN = nN_; nwg = nM * nN; G = G_; c = c_; }
    template <int NM, int NN> __device__ __forceinline__ bool get_c(int i, int& pm, int& pn) const {
        constexpr int NWG = NM * NN; const int L = i * G + c; if (L >= NWG) return false;
        int wgid = L; { constexpr int q = NWG / NXCD, r = NWG % NXCD; const int xcd = wgid % NXCD, off = wgid / NXCD; wgid = (xcd < r ? xcd * (q + 1) : r * (q + 1) + (xcd - r) * q) + off; }
        constexpr int nig = WGM * NN; static_assert(NM % WGM == 0, "full row groups"); const int gid = wgid / nig, fm = gid * WGM;
        pm = fm + ((wgid % nig) % WGM); pn = (wgid % nig) / WGM; return true;
    }
    __device__ __forceinline__ bool get(int i, int& pm, int& pn) const {
        if (nM == 128 && nN == 20) return get_c<128, 20>(i, pm, pn);
        if (nM == 128 && nN == 4) return get_c<128, 4>(i, pm, pn);
        const long L = (long)i * G + c; if (L >= nwg) return false;
        int wgid = (int)L; { const int q = nwg / NXCD, r = nwg % NXCD, xcd = wgid % NXCD, off = wgid / NXCD; wgid = (xcd < r ? xcd * (q + 1) : r * (q + 1) + (xcd - r) * q) + off; }
        const int nig = WGM * nN, gid = wgid / nig, fm = gid * WGM, gsz = (nM - fm) < WGM ? (nM - fm) : WGM;
        pm = fm + ((wgid % nig) % gsz); pn = (wgid % nig) / gsz; return true;
    }
};

__device__ __forceinline__ unsigned cvt_pk_bf16(float lo, float hi) { unsigned r; asm volatile("v_cvt_pk_bf16_f32 %0, %1, %2" : "=v"(r) : "v"(lo), "v"(hi)); return r; }
__device__ __forceinline__ float bf_lo(unsigned w) { return __uint_as_float(w << 16); }
__device__ __forceinline__ float bf_hi(unsigned w) { return __uint_as_float(w & 0xffff0000u); }

template <class Epi, class Sched, bool FP8 = false>
__device__ __forceinline__ void gemm_phase(PG8_LAS unsigned char* lds, const void* Abase, const bf16_t* Bt, const int K, const Sched& S, const Epi& E, const int KBp = 0) {
    const int KB = KBp ? KBp : K;
    int tid_ = threadIdx.x; asm volatile("" : "+v"(tid_));
    const int tid = tid_, wid = __builtin_amdgcn_readfirstlane(tid >> 6), lane = tid & 63, wr = wid >> 2, wc = wid & 3, fr = lane & 15, fq = lane >> 4;
    const int nt = K / BK;
    unsigned voffB[2];
#pragma unroll
    for (int i = 0; i < 2; ++i) { int R, C; stage_rc(tid * 16 + i * 8192, R, C); const int Rb = Epi::PERM ? ((R & ~31) + perm32(R & 31)) : R;
        voffB[i] = (unsigned)(Rb * KB + C) * 2u; }
    const size_t kstep = (size_t)(BK * 2);
    const size_t hstep = (size_t)HALF * KB * 2;
    const size_t tstep = 2 * hstep;
    const unsigned ldsw = (unsigned)wid * 1024u;
    const int aoff = lds_byte(wr * 64 + fr, fq * 8), boff = lds_byte(wc * 32 + fr, fq * 8);
#define PG8_SA(b, h) (((b) * 2 + (h)) * HTB)
#define PG8_SB(b, h) ((4 + (b) * 2 + (h)) * HTB)
#define PG8_STAGE(bufoff, gbase, voff) do { _Pragma("unroll") for (int _i = 0; _i < 2; ++_i) \
        __builtin_amdgcn_global_load_lds((const unsigned*)((const char*)(gbase) + (voff)[_i]), (PG8_LAS unsigned*)(lds + (bufoff) + ldsw + _i * 8192), 16, 0, 0); } while (0)
#define PG8_LDA(dst, b, h) do { _Pragma("unroll") for (int m = 0; m < 4; ++m) _Pragma("unroll") for (int k = 0; k < 2; ++k) dst[m][k] = *(const PG8_LAS bf16x8*)(lds + PG8_SA(b, h) + aoff + m * 2048 + k * 1024); } while (0)
#define PG8_LDB(dst, b, h) do { _Pragma("unroll") for (int n = 0; n < 2; ++n) _Pragma("unroll") for (int k = 0; k < 2; ++k) dst[n][k] = *(const PG8_LAS bf16x8*)(lds + PG8_SB(b, h) + boff + n * 2048 + k * 1024); } while (0)
typedef int v4i_t __attribute__((ext_vector_type(4))); typedef int v8i_t __attribute__((ext_vector_type(8)));
#define PG8_MMA(ai, bj, At, Bt_) do { __builtin_amdgcn_s_setprio(1); _Pragma("unroll") for (int m = 0; m < 4; ++m) _Pragma("unroll") for (int n = 0; n < 2; ++n) { \
        if constexpr (FP8) { const v8i_t a_ = __builtin_shufflevector(__builtin_bit_cast(v4i_t, At[m][0]), __builtin_bit_cast(v4i_t, At[m][1]), 0, 1, 2, 3, 4, 5, 6, 7); \
            const v8i_t b_ = __builtin_shufflevector(__builtin_bit_cast(v4i_t, Bt_[n][0]), __builtin_bit_cast(v4i_t, Bt_[n][1]), 0, 1, 2, 3, 4, 5, 6, 7); \
            acc[ai][bj][m][n] = __builtin_amdgcn_mfma_scale_f32_16x16x128_f8f6f4(b_, a_, acc[ai][bj][m][n], 0, 0, 0, 0x7f7f7f7f, 0, 0x7f7f7f7f); } \
        else { _Pragma("unroll") for (int k = 0; k < 2; ++k) acc[ai][bj][m][n] = __builtin_amdgcn_mfma_f32_16x16x32_bf16(Bt_[n][k], At[m][k], acc[ai][bj][m][n], 0, 0, 0); } } __builtin_amdgcn_s_setprio(0); } while (0)
#define PG8_WAIT_V(n) asm volatile("s_waitcnt vmcnt(" #n ")" ::: "memory")
#define PG8_WAIT_L(n) asm volatile("s_waitcnt lgkmcnt(" #n ")" ::: "memory")
#define PG8_BAR __builtin_amdgcn_s_barrier()
#define PG8_SCHED __builtin_amdgcn_sched_barrier(0)
#define PG8_VRAW(raw, u) do { _Pragma("unroll") for (int _i = 0; _i < 2; ++_i) { int _R, _C; stage_rc(tid * 16 + _i * 8192, _R, _C); _Pragma("unroll") for (int _h = 0; _h < 2; ++_h) raw[_h][_i] = S.a_raw(u, _h * HALF + _R); } } while (0)
#define PG8_VFIN(dst, raw, u) do { _Pragma("unroll") for (int _i = 0; _i < 2; ++_i) { int _R, _C; stage_rc(tid * 16 + _i * 8192, _R, _C); _Pragma("unroll") for (int _h = 0; _h < 2; ++_h) dst[_h][_i] = S.a_fin(u, _h * HALF + _R, raw[_h][_i]) + (unsigned)_C * 2u; } } while (0)
#define PG8_VOFF(dst, u) do { _Pragma("unroll") for (int _i = 0; _i < 2; ++_i) { int _R, _C; stage_rc(tid * 16 + _i * 8192, _R, _C); _Pragma("unroll") for (int _h = 0; _h < 2; ++_h) dst[_h][_i] = S.a_off(u, _h * HALF + _R) + (unsigned)_C * 2u; } } while (0)
    Unit cur, nxt; int ui = 0;
    if (!S.next(0, cur)) return;
    float pf_w = 0.f; int pf_d = 0;
    if constexpr (Epi::PREFETCH) { E.fetch(cur, tid, pf_w, pf_d); E.stash(0, tid, pf_w, pf_d); }
    f32x4 acc[2][2][4][2];
#pragma unroll
    for (int a = 0; a < 2; ++a)
#pragma unroll
        for (int b = 0; b < 2; ++b)
#pragma unroll
            for (int m = 0; m < 4; ++m)
#pragma unroll
                for (int n = 0; n < 2; ++n) acc[a][b][m][n] = (f32x4){0.f, 0.f, 0.f, 0.f};
    bf16x8 At[4][2], B0[2][2], B1[2][2];
    unsigned vc[2][2]; int vn[2][2];
    PG8_VOFF(vc, cur);
    const char* const Ab = (const char*)Abase;
    const char* cB = (const char*)Bt + (size_t)cur.bt * tstep;
    PG8_STAGE(PG8_SB(0, 0), cB, voffB); PG8_STAGE(PG8_SB(0, 1), cB + hstep, voffB); PG8_STAGE(PG8_SA(0, 0), Ab, vc[0]); PG8_STAGE(PG8_SA(0, 1), Ab, vc[1]);
    if (wr == 1) PG8_BAR;
    PG8_WAIT_V(2); PG8_BAR;
    PG8_STAGE(PG8_SB(1, 0), cB + kstep, voffB); PG8_STAGE(PG8_SA(1, 0), Ab + kstep, vc[0]); PG8_STAGE(PG8_SB(1, 1), cB + hstep + kstep, voffB);
    PG8_WAIT_V(6); PG8_BAR;
    for (;;) {
        const bool has_next = S.next(ui + 1, nxt);
        if constexpr (Epi::PREFETCH) { if (has_next) E.fetch(nxt, tid, pf_w, pf_d); }
        if constexpr (Sched::EARLY_VOFF) { if (has_next) { PG8_VRAW(vn, nxt); } }
        const char* nB = has_next ? (const char*)Bt + (size_t)nxt.bt * tstep : cB;
#pragma unroll 1
        for (int t = 0; t < nt; t += 2) {
            const bool last = (t == nt - 2);
            const char* a1 = Ab + (size_t)(t + 1) * kstep;
            const char* a2 = last ? Ab : Ab + (size_t)(t + 2) * kstep; const char* b2 = last ? nB : cB + (size_t)(t + 2) * kstep;
            const char* a3 = a2 + kstep; const char* b3 = b2 + kstep;
            PG8_LDB(B0, 0, 0); PG8_LDB(B1, 0, 1); PG8_SCHED; PG8_LDA(At, 0, 0); PG8_STAGE(PG8_SA(1, 1), a1, vc[1]);
            if (last && has_next) { if constexpr (Sched::EARLY_VOFF) { PG8_VFIN(vc, vn, nxt); } else { PG8_VOFF(vc, nxt); } }
            PG8_WAIT_V(8); PG8_WAIT_L(0); PG8_BAR; PG8_MMA(0, 0, At, B0); PG8_MMA(0, 1, At, B1); PG8_BAR; PG8_SCHED;
            PG8_LDA(At, 0, 1); PG8_STAGE(PG8_SB(0, 0), b2, voffB); PG8_STAGE(PG8_SB(0, 1), b2 + hstep, voffB); PG8_STAGE(PG8_SA(0, 0), a2, vc[0]);
            PG8_WAIT_V(8); PG8_WAIT_L(0); PG8_BAR; PG8_MMA(1, 0, At, B0); PG8_MMA(1, 1, At, B1); PG8_BAR; PG8_SCHED;
            PG8_LDB(B0, 1, 0); PG8_LDB(B1, 1, 1); PG8_SCHED; PG8_LDA(At, 1, 0); PG8_STAGE(PG8_SA(0, 1), a2, vc[1]);
            PG8_WAIT_V(8); PG8_WAIT_L(0); PG8_BAR; PG8_MMA(0, 0, At, B0); PG8_MMA(0, 1, At, B1); PG8_BAR; PG8_SCHED;
            PG8_LDA(At, 1, 1); PG8_STAGE(PG8_SB(1, 0), b3, voffB); PG8_STAGE(PG8_SB(1, 1), b3 + hstep, voffB); PG8_STAGE(PG8_SA(1, 0), a3, vc[0]);
            PG8_WAIT_V(8); PG8_WAIT_L(0); PG8_BAR; PG8_MMA(1, 0, At, B0); PG8_MMA(1, 1, At, B1); PG8_BAR; PG8_SCHED;
        }
        if (wr == 0) PG8_BAR;
        if constexpr (Epi::PREFETCH) { if (has_next) E.stash((ui + 1) & 1, tid, pf_w, pf_d); E(acc, cur, wr, wc, fr, fq, ui & 1); } else
        E(acc, cur, wr, wc, fr, fq);
#ifdef PROBE_DUPEPI
        if constexpr (Epi::ID == PROBE_DUPEPI) { asm volatile("" ::: "memory"); if constexpr (Epi::PREFETCH) E(acc, cur, wr, wc, fr, fq, ui & 1); else E(acc, cur, wr, wc, fr, fq); asm volatile("" ::: "memory"); }
#endif
        if (!has_next) break;
#pragma unroll
        for (int a = 0; a < 2; ++a)
#pragma unroll
            for (int b = 0; b < 2; ++b)
#pragma unroll
                for (int m = 0; m < 4; ++m)
#pragma unroll
                    for (int n = 0; n < 2; ++n) { typedef double d2_t __attribute__((ext_vector_type(2))); d2_t z_; asm volatile("v_mov_b64 %0, 0\n\tv_mov_b64 %1, 0" : "=v"(z_.x), "=v"(z_.y)); acc[a][b][m][n] = __builtin_bit_cast(f32x4, z_); }
        cur = nxt; cB = nB; ++ui;
        if (wr == 1) PG8_BAR;
    }
    PG8_WAIT_V(0);
    PG8_BAR;
#undef PG8_SA
#undef PG8_SB
#undef PG8_STAGE
#undef PG8_LDA
#undef PG8_LDB
#undef PG8_MMA
#undef PG8_WAIT_V
#undef PG8_WAIT_L
#undef PG8_BAR
#undef PG8_SCHED
#undef PG8_VOFF
#undef PG8_VRAW
#undef PG8_VFIN
}
}
namespace att {
#define ATT_LAS __attribute__((address_space(3)))
typedef unsigned short bf16_t;
using bf16x8 = __attribute__((ext_vector_type(8))) short;
using s16x4 = __attribute__((ext_vector_type(4))) short;
using f32x16 = __attribute__((ext_vector_type(16))) float;
using u32x4 = __attribute__((ext_vector_type(4))) unsigned;
typedef float f32x4 __attribute__((ext_vector_type(4)));
constexpr int PITCH = 512, SEQ = 4096, NH = 8, D = 64;
constexpr float LOG2E = 1.4426950408889634f;
constexpr int L_BUF = 16384  , L_BIAS = 32768, L_REL = 33280, L_WS = 34560, L_OST = 36608, LDS_BYTES = L_OST + 8 * 4096;
__device__ __forceinline__ int crow(int r, int hi) { return (r & 3) + 8 * (r >> 2) + 4 * hi; }
typedef float f32x2_t __attribute__((ext_vector_type(2))); typedef __bf16 bf16x2_t __attribute__((ext_vector_type(2)));
__device__ __forceinline__ unsigned cvtpk_s(float lo, float hi) { f32x2_t v = {lo, hi}; bf16x2_t b = __builtin_convertvector(v, bf16x2_t); return __builtin_bit_cast(unsigned, b); }
__device__ __forceinline__ unsigned short f2bf(float f) { unsigned u = __builtin_bit_cast(unsigned, f); return (unsigned short)((u + 0x7fffu + ((u >> 16) & 1u)) >> 16); }

template <int MODE>
__device__ __forceinline__ void attn_unit(int b, int h, int ub, const bf16_t* Q, const bf16_t* __restrict__ K, const bf16_t* __restrict__ V, bf16_t* O,
                                          const float* __restrict__ cum  , const float* __restrict__ rel  , ATT_LAS unsigned char* shm) {
    int tid_ = threadIdx.x; asm volatile("" : "+v"(tid_));
    const int tid = tid_, lane = tid & 63, r32 = lane & 31, hi = lane >> 5; const int wid = __builtin_amdgcn_readfirstlane(tid >> 6);
    const long rowbase = (long)b * SEQ; const int q0 = ub * 256;
    const bf16_t* Qw = Q + (rowbase + q0 + wid * 32) * PITCH + h * D;
    const bf16_t* Kh = K + rowbase * PITCH + h * D; const bf16_t* Vh = V + rowbase * PITCH + h * D;
    ATT_LAS float* biasl = (ATT_LAS float*)(shm + L_BIAS);
    ATT_LAS float* rell = (ATT_LAS float*)(shm + L_REL);
    ATT_LAS float* wsf = (ATT_LAS float*)(shm + L_WS) + wid * 64;
    int t_lo, t_hi, wt_lo, wt_hi, cw = 0;
    if (MODE == 0) { t_lo = 0; t_hi = (q0 + 256) / 64 - 1; wt_lo = 0; wt_hi = (q0 + wid * 32 + 31) / 64; }
    else { cw = 4 * ub + (wid >> 1); wt_lo = cw - 8 < 0 ? 0 : cw - 8; wt_hi = cw; t_lo = 4 * ub - 8 < 0 ? 0 : 4 * ub - 8; t_hi = 4 * ub + 3; }
    const float cq0 = (MODE == 0) ? cum[(b * NH + h) * SEQ + q0] : 0.f;
    const float rfar = (MODE == 1) ? rel[h * 257 + 256] * LOG2E : 0.f;
    bf16x8 qr[4];
#pragma unroll
    for (int d0 = 0; d0 < 4; ++d0) qr[d0] = *reinterpret_cast<const bf16x8*>(&Qw[(long)r32 * PITCH + d0 * 16 + hi * 8]);
    float mrun = -1e30f, lrun = 0.f; f32x16 o[2]; o[0] = f32x16{}; o[1] = f32x16{};
    const int qabs = q0 + wid * 32 + r32;
    const bf16_t* ksrc = Kh + (long)lane * PITCH + wid * 8;
    const bf16_t* vsrc = Vh + (long)(16 * (wid & 3) + (lane >> 2)) * PITCH + (wid >> 2) * 32 + (lane & 3) * 8;
    ATT_LAS unsigned char* kdst = shm + wid * 1024 + lane * 16;
    ATT_LAS unsigned char* vdst = shm + 8192 + wid * 1024 + lane * 16;
    const unsigned vb0 = (unsigned)(uintptr_t)(shm + 8192) + ((lane >> 4) & 1) * 32 + (lane & 3) * 8 + (4 * hi + ((lane & 15) >> 2)) * 64;
    const ATT_LAS unsigned char* kb0 = shm + hi * 1024 + r32 * 16;
    __syncthreads();
    if (MODE == 1) { for (int i = tid; i < 320; i += 512) rell[i] = rel[h * 257 + (i < 256 ? i : 256)] * LOG2E; }
    { const u32x4 k0 = *(const u32x4*)(ksrc + (long)t_lo * 64 * PITCH), v0 = *(const u32x4*)(vsrc + (long)t_lo * 64 * PITCH);
      *(ATT_LAS u32x4*)(kdst + (t_lo & 1) * L_BUF) = k0; *(ATT_LAS u32x4*)(vdst + (t_lo & 1) * L_BUF) = v0;
      if (MODE == 0 && wid == 0) biasl[(t_lo & 1) * 64 + lane] = (cq0 - cum[(b * NH + h) * SEQ + t_lo * 64 + lane]) * LOG2E; }
    static_assert(MODE == 1, "chunk-band mixer only (the FoX mixer has its own pipelined body)");
    u32x4 kA = (u32x4){0u, 0u, 0u, 0u}, vA = kA, kB = kA, vB = kA;
#define ATT_GLD(dst, ptr) asm volatile("global_load_dwordx4 %0, %1, off" : "=&v"(dst) : "v"(ptr) : "memory")
    asm volatile("s_waitcnt vmcnt(0)" ::: "memory");
    ATT_GLD(kA, ksrc + (long)(t_lo + 1) * 64 * PITCH); ATT_GLD(vA, vsrc + (long)(t_lo + 1) * 64 * PITCH);
    ATT_GLD(kB, ksrc + (long)(t_lo + 2) * 64 * PITCH); ATT_GLD(vB, vsrc + (long)(t_lo + 2) * 64 * PITCH);
    auto step = [&](const int t, u32x4& kreg, u32x4& vreg) __attribute__((always_inline)) {
        asm volatile("s_waitcnt lgkmcnt(0)\n\ts_barrier" ::: "memory");
        asm volatile("s_waitcnt vmcnt(2)" : "+v"(kreg), "+v"(vreg) :: "memory");
        if (t < t_hi) {
            *(ATT_LAS u32x4*)(kdst + ((t + 1) & 1) * L_BUF) = kreg; *(ATT_LAS u32x4*)(vdst + ((t + 1) & 1) * L_BUF) = vreg;
        }
        asm volatile("s_waitcnt lgkmcnt(0)" ::: "memory");
        { const int tl = (t + 3 <= t_hi) ? t + 3 : t_hi;
          ATT_GLD(kreg, ksrc + (long)tl * 64 * PITCH); ATT_GLD(vreg, vsrc + (long)tl * 64 * PITCH); }
        if (t >= wt_lo && t <= wt_hi) {
            const int bo = (t & 1) * L_BUF; const ATT_LAS unsigned char* kb = kb0 + bo; const unsigned vbt = vb0 + bo;
            f32x16 p0 = f32x16{}, p1 = f32x16{};
            if (MODE == 0) {
                const ATT_LAS float* bl = biasl + (t & 1) * 64 + 4 * hi;
#pragma unroll
                for (int g = 0; g < 4; ++g) { const f32x4 bA = *(const ATT_LAS f32x4*)(bl + 8 * g), bB = *(const ATT_LAS f32x4*)(bl + 32 + 8 * g);
#pragma unroll
                    for (int i = 0; i < 4; ++i) { p0[4 * g + i] = bA[i]; p1[4 * g + i] = bB[i]; } }
            }
            { bf16x8 kf[8];
#pragma unroll
              for (int d0 = 0; d0 < 4; ++d0) { kf[2 * d0] = *reinterpret_cast<const ATT_LAS bf16x8*>(kb + d0 * 2048); kf[2 * d0 + 1] = *reinterpret_cast<const ATT_LAS bf16x8*>(kb + d0 * 2048 + 512); }
              __builtin_amdgcn_sched_barrier(0);
#pragma unroll
              for (int d0 = 0; d0 < 4; ++d0) { p0 = __builtin_amdgcn_mfma_f32_32x32x16_bf16(kf[2 * d0], qr[d0], p0, 0, 0, 0); p1 = __builtin_amdgcn_mfma_f32_32x32x16_bf16(kf[2 * d0 + 1], qr[d0], p1, 0, 0, 0); }
              __builtin_amdgcn_sched_barrier(0); }
            float cst = 0.f;
            if (MODE == 0) {
                if (64 * t + 63 > q0 + wid * 32) {
#pragma unroll
                    for (int r = 0; r < 16; ++r) { const int kv = 64 * t + crow(r, hi); p0[r] = (kv > qabs) ? -INFINITY : p0[r]; p1[r] = (kv + 32 > qabs) ? -INFINITY : p1[r]; } }
            } else {
                if (cw - t <= 2) {
                    const unsigned rba = (unsigned)(uintptr_t)(rell + (qabs - 64 * t - 4 * hi + 128 - 59));
                    f32x2_t b0_[8], b1_[8];
#pragma unroll
                    for (int j2 = 0; j2 < 8; ++j2) { const int c_ = ((2 * j2) & 3) + 8 * ((2 * j2) >> 2);
                        asm volatile("ds_read2_b32 %0, %1 offset0:%c2 offset1:%c3" : "=&v"(b0_[j2]) : "v"(rba), "i"(58 - c_), "i"(59 - c_) : "memory");
                        asm volatile("ds_read2_b32 %0, %1 offset0:%c2 offset1:%c3" : "=&v"(b1_[j2]) : "v"(rba), "i"(26 - c_), "i"(27 - c_) : "memory"); }
                    asm volatile("s_waitcnt lgkmcnt(0)" ::: "memory");
#pragma unroll
                    for (int j2 = 0; j2 < 8; ++j2) { p0[2 * j2] += b0_[j2].y; p0[2 * j2 + 1] += b0_[j2].x; p1[2 * j2] += b1_[j2].y; p1[2 * j2 + 1] += b1_[j2].x; }
                } else cst = rfar;
            }
            float rm = fmaxf(fmaxf(p0[0], p0[1]), p0[2]);
#pragma unroll
            for (int r = 3; r < 15; r += 2) rm = fmaxf(fmaxf(rm, p0[r]), p0[r + 1]);
            rm = fmaxf(rm, p0[15]);
#pragma unroll
            for (int r = 0; r < 16; r += 2) rm = fmaxf(fmaxf(rm, p1[r]), p1[r + 1]);
            rm = fmaxf(rm, __shfl_xor(rm, 32)) + cst;
            const float mnew = fmaxf(mrun, rm); const float alpha = __builtin_amdgcn_exp2f(mrun - mnew); const bool grew = mnew > mrun; mrun = mnew;
            const float sub = mnew - cst;
            float sacc = 0.f;
#pragma unroll
            for (int r = 0; r < 16; ++r) { p0[r] = __builtin_amdgcn_exp2f(p0[r] - sub); p1[r] = __builtin_amdgcn_exp2f(p1[r] - sub); sacc += p0[r] + p1[r]; }
            lrun = lrun * alpha + sacc;
            if (__any(grew)) {
                if (hi == 0) wsf[r32] = alpha;
                asm volatile("s_waitcnt lgkmcnt(0)" ::: "memory");
#pragma unroll
                for (int r = 0; r < 16; ++r) { const float f = wsf[crow(r, hi)]; o[0][r] *= f; o[1][r] *= f; }
            }
            u32x4 pw0, pw1, pw2, pw3;
            pw0 = (u32x4){cvtpk_s(p0[0], p0[1]), cvtpk_s(p0[2], p0[3]), cvtpk_s(p0[4], p0[5]), cvtpk_s(p0[6], p0[7])};
            pw1 = (u32x4){cvtpk_s(p0[8], p0[9]), cvtpk_s(p0[10], p0[11]), cvtpk_s(p0[12], p0[13]), cvtpk_s(p0[14], p0[15])};
            pw2 = (u32x4){cvtpk_s(p1[0], p1[1]), cvtpk_s(p1[2], p1[3]), cvtpk_s(p1[4], p1[5]), cvtpk_s(p1[6], p1[7])};
            pw3 = (u32x4){cvtpk_s(p1[8], p1[9]), cvtpk_s(p1[10], p1[11]), cvtpk_s(p1[12], p1[13]), cvtpk_s(p1[14], p1[15])};
            const bf16x8 pa0 = __builtin_bit_cast(bf16x8, pw0), pa1 = __builtin_bit_cast(bf16x8, pw1), pa2 = __builtin_bit_cast(bf16x8, pw2), pa3 = __builtin_bit_cast(bf16x8, pw3);
#pragma unroll
            for (int d0 = 0; d0 < 2; ++d0) { s16x4 lo[4], hh[4];
#pragma unroll
                for (int ks = 0; ks < 4; ++ks) {
                    asm volatile("ds_read_b64_tr_b16 %0,%1 offset:%c2" : "=&v"(lo[ks]) : "v"(vbt), "i"(d0 * 4096 + ks * 1024) : "memory");
                    asm volatile("ds_read_b64_tr_b16 %0,%1 offset:%c2" : "=&v"(hh[ks]) : "v"(vbt), "i"(d0 * 4096 + ks * 1024 + 512) : "memory"); }
                asm volatile("s_waitcnt lgkmcnt(0)" ::: "memory"); __builtin_amdgcn_sched_barrier(0);
#define ATT_PK(k) (bf16x8){lo[k][0], lo[k][1], lo[k][2], lo[k][3], hh[k][0], hh[k][1], hh[k][2], hh[k][3]}
                o[d0] = __builtin_amdgcn_mfma_f32_32x32x16_bf16(pa0, ATT_PK(0), o[d0], 0, 0, 0);
                o[d0] = __builtin_amdgcn_mfma_f32_32x32x16_bf16(pa1, ATT_PK(1), o[d0], 0, 0, 0);
                o[d0] = __builtin_amdgcn_mfma_f32_32x32x16_bf16(pa2, ATT_PK(2), o[d0], 0, 0, 0);
                o[d0] = __builtin_amdgcn_mfma_f32_32x32x16_bf16(pa3, ATT_PK(3), o[d0], 0, 0, 0);
#undef ATT_PK
            }
        }
    };
    for (int t = t_lo; t <= t_hi; t += 2) { step(t, kA, vA); step(t + 1, kB, vB); }
    asm volatile("s_waitcnt vmcnt(0)" : "+v"(kA), "+v"(vA), "+v"(kB), "+v"(vB) :: "memory");
#undef ATT_GLD
    lrun += __shfl_xor(lrun, 32);
    if (hi == 0) wsf[32 + r32] = lrun;
    asm volatile("s_waitcnt lgkmcnt(0)" ::: "memory");
    float rli[16];
#pragma unroll
    for (int r = 0; r < 16; ++r) rli[r] = __builtin_amdgcn_rcpf(wsf[32 + crow(r, hi)]);
    unsigned char* Ow = (unsigned char*)O + (rowbase + q0 + wid * 32) * 512 + h * D;
    { ATT_LAS unsigned char* stg = (ATT_LAS unsigned char*)(shm + L_OST) + wid * 2048;
#pragma unroll
      for (int r = 0; r < 16; ++r) { const int orow = crow(r, hi);
#pragma unroll
          for (int d0 = 0; d0 < 2; ++d0) { const float y_ = __builtin_amdgcn_fmed3f(o[d0][r] * rli[r] * 16.0f, -440.f, 440.f); stg[orow * 64 + d0 * 32 + r32] = (unsigned char)(__builtin_amdgcn_cvt_pk_fp8_f32(y_, y_, 0, false) & 0xff); } }
      asm volatile("s_waitcnt lgkmcnt(0)" ::: "memory");
#pragma unroll
      for (int i = 0; i < 2; ++i) { const int row = i * 16 + (lane >> 2), ch = lane & 3; const u32x4 v = *(const ATT_LAS u32x4*)(stg + row * 64 + ch * 16); *(u32x4*)(Ow + (long)row * 512 + ch * 16) = v; } }
}
}
namespace fox {
using bf16=__hip_bfloat16;
using bf16x8=__attribute__((ext_vector_type(8)))short;
using s16x4=__attribute__((ext_vector_type(4)))short;
using f32x16=__attribute__((ext_vector_type(16)))float;
using u32x4=__attribute__((ext_vector_type(4)))unsigned;
constexpr int SEQ=4096,D=64,DM=512;
constexpr int NW=8,QBLK=32,QB=QBLK*NW,KVBLK=64,NQB=SEQ/QB;
constexpr int ATTN_PITCH=DM, ATTN_UNIT_ROWS=QB;
__device__ __forceinline__ int crow(int r,int hi){return (r&3)+8*(r>>2)+4*hi;}
#define SBAR() __builtin_amdgcn_sched_barrier(0)
__device__ __forceinline__ void cmask(f32x16&p0,f32x16&p1,int jb,int qrel,int hi){
  const float NEG=-INFINITY; int kb=64*jb+4*hi;
  #pragma unroll
  for(int r=0;r<16;++r){int kv=kb+(r&3)+8*(r>>2); if(kv>qrel)p0[r]=NEG; if(kv+32>qrel)p1[r]=NEG;}
}

constexpr int NSLOT=3, SLOTB=8192;
constexpr int LDS_K=0, LDS_V=NSLOT*SLOTB, LDS_WS=2*NSLOT*SLOTB, LDS_OST=LDS_WS+NW*64*4, LDS_BIAS=LDS_OST+NW*4096, LDS_BYTES=LDS_BIAS+SEQ*8+1024;
constexpr float C2=0.125f*1.4426950408889634f;
__device__ __forceinline__ void glds16(const void*gsrc,unsigned lds_dst){unsigned keep;
  asm volatile("s_mov_b32 %0, m0\n\ts_mov_b32 m0, %2\n\ts_nop 0\n\tglobal_load_lds_dwordx4 %1, off\n\ts_mov_b32 m0, %0":"=&s"(keep):"v"(gsrc),"s"(lds_dst):"memory");}
__device__ __forceinline__ float max3f(float a,float b,float c){float r;asm("v_max3_f32 %0, %1, %2, %3":"=v"(r):"v"(a),"v"(b),"v"(c));return r;}
__device__ __forceinline__ float max2f(float a,float b){float r;asm("v_max_f32_e32 %0, %1, %2":"=v"(r):"v"(a),"v"(b));return r;}
__device__ __forceinline__ float fadd_s(float a,float b){float r;asm("v_add_f32_e32 %0, %1, %2":"=v"(r):"v"(a),"v"(b));return r;}
__device__ __forceinline__ float fsub_s(float a,float b){float r;asm("v_sub_f32_e32 %0, %1, %2":"=v"(r):"v"(a),"v"(b));return r;}
typedef float f32x2_t __attribute__((ext_vector_type(2))); typedef __bf16 bf16x2_t __attribute__((ext_vector_type(2)));
__device__ __forceinline__ unsigned cvtpk_s(float lo,float hi){f32x2_t v={lo,hi};bf16x2_t b=__builtin_convertvector(v,bf16x2_t);return __builtin_bit_cast(unsigned,b);}
#define WAIT_BAR(N) asm volatile("s_waitcnt vmcnt(" #N ") lgkmcnt(0)\n\ts_barrier":::"memory")

__device__ __forceinline__ void qkt(f32x16&p0,f32x16&p1,const char*Kslot,const bf16x8*qr,bf16x8 ka0,bf16x8 ka1,bf16x8 qa,int r32,int hi){
  p0=__builtin_amdgcn_mfma_f32_32x32x16_bf16(ka0,qa,f32x16{},0,0,0);p1=__builtin_amdgcn_mfma_f32_32x32x16_bf16(ka1,qa,f32x16{},0,0,0);
  const char*kb=Kslot+hi*1024+r32*16;
  #pragma unroll
  for(int d0=0;d0<4;++d0){
    const bf16x8 b0=*reinterpret_cast<const bf16x8*>(kb+d0*2048);
    const bf16x8 b1=*reinterpret_cast<const bf16x8*>(kb+d0*2048+512);
    p0=__builtin_amdgcn_mfma_f32_32x32x16_bf16(b0,qr[d0],p0,0,0,0);p1=__builtin_amdgcn_mfma_f32_32x32x16_bf16(b1,qr[d0],p1,0,0,0);}
}
typedef __attribute__((address_space(3))) const char* lds_cptr;
typedef short v4i16_t __attribute__((ext_vector_type(4)));
__device__ __forceinline__ void kload8(bf16x8*kf,lds_cptr kp){
  kf[0]=*(const __attribute__((address_space(3))) bf16x8*)(kp);      kf[1]=*(const __attribute__((address_space(3))) bf16x8*)(kp+512);
  kf[2]=*(const __attribute__((address_space(3))) bf16x8*)(kp+2048); kf[3]=*(const __attribute__((address_space(3))) bf16x8*)(kp+2560);
  kf[4]=*(const __attribute__((address_space(3))) bf16x8*)(kp+4096); kf[5]=*(const __attribute__((address_space(3))) bf16x8*)(kp+4608);
  kf[6]=*(const __attribute__((address_space(3))) bf16x8*)(kp+6144); kf[7]=*(const __attribute__((address_space(3))) bf16x8*)(kp+6656);
}
__device__ __forceinline__ void kload2(bf16x8*kf,lds_cptr kp,int j){ kf[2*j]=*(const __attribute__((address_space(3))) bf16x8*)(kp+j*2048); kf[2*j+1]=*(const __attribute__((address_space(3))) bf16x8*)(kp+j*2048+512); }
__device__ __forceinline__ s16x4 vtr(lds_cptr p){ return __builtin_bit_cast(s16x4,__builtin_amdgcn_ds_read_tr16_b64_v4i16((__attribute__((address_space(3))) v4i16_t*)p)); }
__device__ __forceinline__ float rowmax(const f32x16&p0,const f32x16&p1){
  float a=max3f(p0[0],p0[1],p1[0]),b=max3f(p0[2],p0[3],p1[1]);a=max3f(a,p1[2],p1[3]);
  #pragma unroll
  for(int r=4;r<16;r+=4){a=max3f(a,p0[r],p0[r+1]);b=max3f(b,p0[r+2],p0[r+3]);a=max3f(a,p1[r],p1[r+1]);b=max3f(b,p1[r+2],p1[r+3]);}
  const float m=max2f(a,b);
  auto rr=__builtin_amdgcn_permlane32_swap(__float_as_uint(m),__float_as_uint(m),false,false);
  return max2f(__uint_as_float(rr[0]),__uint_as_float(rr[1]));
}
__device__ __forceinline__ void pv(f32x16*o,int vb,bf16x8 pa0,bf16x8 pa1,bf16x8 pa2,bf16x8 pa3){
  #pragma unroll
  for(int d0=0;d0<2;++d0){s16x4 lo[4],hi[4];
    #pragma unroll
    for(int ks=0;ks<4;++ks){
      asm volatile("ds_read_b64_tr_b16 %0,%1 offset:%c2":"=&v"(lo[ks]):"v"(vb),"i"(d0*4096+ks*1024):"memory");
      asm volatile("ds_read_b64_tr_b16 %0,%1 offset:%c2":"=&v"(hi[ks]):"v"(vb),"i"(d0*4096+ks*1024+512):"memory");}
    asm volatile("s_waitcnt lgkmcnt(0)":::"memory");SBAR();
    #define PK(k) (bf16x8){lo[k][0],lo[k][1],lo[k][2],lo[k][3],hi[k][0],hi[k][1],hi[k][2],hi[k][3]}
    o[d0]=__builtin_amdgcn_mfma_f32_32x32x16_bf16(pa0,PK(0),o[d0],0,0,0);
    o[d0]=__builtin_amdgcn_mfma_f32_32x32x16_bf16(pa1,PK(1),o[d0],0,0,0);
    o[d0]=__builtin_amdgcn_mfma_f32_32x32x16_bf16(pa2,PK(2),o[d0],0,0,0);
    o[d0]=__builtin_amdgcn_mfma_f32_32x32x16_bf16(pa3,PK(3),o[d0],0,0,0);
    #undef PK
  }
}

__device__ __forceinline__ void split3(float x,unsigned&h,unsigned&m,unsigned&l){
  h=cvtpk_s(x,0.f)&0xffffu; const float r1=x-__uint_as_float(h<<16); m=cvtpk_s(r1,0.f)&0xffffu; const float r2=r1-__uint_as_float(m<<16); l=cvtpk_s(r2,0.f)&0xffffu; }
__device__ __forceinline__ bf16x8 mk_kaug(float bias,int hi){ unsigned h,m,l; split3(bias,h,m,l); u32x4 w; w.x=hi?0u:(h|(m<<16)); w.y=hi?0u:(l|0x3f800000u); w.z=hi?0u:0x3f803f80u; w.w=0u; return __builtin_bit_cast(bf16x8,w); }
__device__ __forceinline__ bf16x8 mk_qaug(float nref,int hi){ unsigned h,m,l; split3(nref,h,m,l); u32x4 w; w.x=hi?0u:0x3f803f80u; w.y=hi?0u:(0x3f80u|(h<<16)); w.z=hi?0u:(m|(l<<16)); w.w=0u; return __builtin_bit_cast(bf16x8,w); }
__device__ __forceinline__ void prep_kaug(const float*__restrict__ cumbh,char*shm){
  unsigned long long*tabU=(unsigned long long*)(shm+LDS_BIAS);
  int t0_=threadIdx.x; asm volatile("":"+v"(t0_));
  float cv[9];
  #pragma unroll
  for(int k=0;k<9;++k){ const int i=t0_+k*NW*64; cv[k]=(i<SEQ)?cumbh[i]:0.f; }
  #pragma unroll
  for(int k=0;k<9;++k){ const int i=t0_+k*NW*64; if(i<SEQ+64){ const float b=(i<SEQ)?-cv[k]*1.4426950408889634f:0.f; unsigned h,m,l; split3(b,h,m,l); tabU[i]=(unsigned long long)(h|(m<<16))|((unsigned long long)(l|0x3f800000u)<<32); } }
}
#ifndef ATTN_STORE16
#define ATTN_STORE16(p,v) (*(u32x4*)(p)=(v))
#endif
template<int THRL> __device__ __forceinline__ void attn_unit(int b,int h,int qb,const bf16*Q,const bf16*__restrict__ K,const bf16*__restrict__ V,bf16*O,const float*__restrict__ cumbh,char*shm){
  int tid_=threadIdx.x; asm volatile("":"+v"(tid_)); const int tid=tid_,lane=tid&63,r32=lane&31,hi=lane>>5; const int wid=__builtin_amdgcn_readfirstlane(tid>>6);
  const long rowbase=(long)b*SEQ; const int q0=qb*QB;
  const bf16*Qw=Q+(rowbase+q0+wid*QBLK)*DM+h*D;
  const bf16*Kh=K+rowbase*DM+h*D,*Vh=V+rowbase*DM+h*D;
  const unsigned lds0=(unsigned)(uintptr_t)shm;
  float*wsf=(float*)(shm+LDS_WS)+wid*64;
  const bf16*ksrc=Kh+(long)lane*DM+wid*8;
  const bf16*vsrc=Vh+(long)(16*(wid&3)+(lane>>2))*DM+(wid>>2)*32+(lane&3)*8;
  const unsigned kdst=lds0+LDS_K+wid*1024, vdst=lds0+LDS_V+wid*1024;
  #define DMA_K(t,slot) glds16(ksrc+(long)(t)*KVBLK*DM,(unsigned)__builtin_amdgcn_readfirstlane(kdst+(slot)))
  #define DMA_V(t,slot) glds16(vsrc+(long)(t)*KVBLK*DM,(unsigned)__builtin_amdgcn_readfirstlane(vdst+(slot)))
  const int vb0=(int)(lds0+LDS_V)+((lane>>4)&1)*32+(lane&3)*8+(4*hi+((lane&15)>>2))*64;
  const char*Kbase=shm+LDS_K; bf16x8 kf[8];
  const lds_cptr shm3=(lds_cptr)shm; const lds_cptr kp0=shm3+LDS_K+hi*1024+r32*16; const lds_cptr vp0=shm3+LDS_V+((lane>>4)&1)*32+(lane&3)*8+(4*hi+((lane&15)>>2))*64;
  const int NT=(q0+QB)/KVBLK;
  const unsigned long long*tabU=(const unsigned long long*)(shm+LDS_BIAS);
  const float bq=-cumbh[q0+wid*QBLK+r32]*1.4426950408889634f;
  asm volatile("s_waitcnt vmcnt(0)":::"memory");
  DMA_K(0,0);DMA_V(0,0);DMA_K(1,SLOTB);
  bf16x8 qr[4];
  #pragma unroll
  for(int d0=0;d0<4;++d0)qr[d0]=*reinterpret_cast<const bf16x8*>(&Qw[(long)r32*DM+d0*16+hi*8]);
  float mhat=0.f,l_reg=0.f;f32x16 o[2];o[0]=f32x16{};o[1]=f32x16{}; bf16x8 qaug=mk_qaug(-bq,hi),kaug0,kaug1;
  #define KAUG(tn) do{ const unsigned long long e0_=tabU[(tn)*KVBLK+r32],e1_=tabU[(tn)*KVBLK+32+r32]; \
    u32x4 w0_,w1_; w0_.x=hi?0u:(unsigned)e0_; w0_.y=hi?0u:(unsigned)(e0_>>32); w0_.z=hi?0u:0x3f803f80u; w0_.w=0u; w1_.x=hi?0u:(unsigned)e1_; w1_.y=hi?0u:(unsigned)(e1_>>32); w1_.z=w0_.z; w1_.w=0u; \
    kaug0=__builtin_bit_cast(bf16x8,w0_); kaug1=__builtin_bit_cast(bf16x8,w1_); }while(0)
  const int qrel=wid*QBLK+r32;
  #define CMASK(P0,P1,t) do{int jb_=(t)-(NT-4); if(jb_>=0)cmask(P0,P1,jb_,qrel,hi);}while(0)
  bool resc=false;
  #define START(P0,P1) do{ const float rm=rowmax(P0,P1); resc=false; \
    if(__builtin_expect(__any(rm>(float)THRL),0)){ const float dl=__builtin_fmaxf(rm,0.f); mhat=fadd_s(mhat,dl); \
      _Pragma("unroll") for(int r=0;r<16;++r){P0[r]=fsub_s(P0[r],dl);P1[r]=fsub_s(P1[r],dl);} \
      qaug=mk_qaug(-(bq+mhat),hi); } \
    _Pragma("unroll") for(int r=0;r<16;++r)P0[r]=__builtin_amdgcn_exp2f(P0[r]); }while(0)
  #define RESC() do{ if(resc){ asm volatile("s_waitcnt lgkmcnt(0)":::"memory"); \
      _Pragma("unroll") for(int d_=0;d_<2;++d_) _Pragma("unroll") for(int r=0;r<16;++r)o[d_][r]*=wsf[crow(r,hi)]; } }while(0)
  f32x16 pA0,pA1,pB0,pB1;
  int sl_prev=0,sl_cur=0,sl_next=SLOTB;
  #define ROT() do{sl_prev=sl_cur;sl_cur=sl_next;sl_next=(sl_next==(NSLOT-1)*SLOTB)?0:sl_next+SLOTB;}while(0)
  DMA_K(2,2*SLOTB);
  WAIT_BAR(3);
  KAUG(0);
  qkt(pA0,pA1,Kbase,qr,kaug0,kaug1,qaug,r32,hi);asm volatile("s_nop 15\n\ts_nop 7":"+v"(pA0),"+v"(pA1));CMASK(pA0,pA1,0);
  START(pA0,pA1);
  _Pragma("unroll") for(int r=0;r<16;++r)pA1[r]=__builtin_amdgcn_exp2f(pA1[r]);
  WAIT_BAR(0);
  DMA_K(3,0);DMA_V(1,SLOTB);
  ROT();
  kload8(kf,kp0+sl_cur);
  KAUG(1);
  WAIT_BAR(2);
  s16x4 vlo[8],vhi[8]; u32x4 pw0,pw1,pw2,pw3;
  #define PKW(P,B) cvtpk_s(P[B],P[B+1])
  #define PAF(k) __builtin_bit_cast(bf16x8,pw##k)
  #define VFR(i) (bf16x8){vlo[i][0],vlo[i][1],vlo[i][2],vlo[i][3],vhi[i][0],vhi[i][1],vhi[i][2],vhi[i][3]}
  #define PIN(x) asm volatile("":"+v"(x))
  #define MX3(a,b,c) __builtin_fmaxf(__builtin_fmaxf((a),(b)),(c))
  #define GAPA(MF,A0,A1,A2,A3,W0,W1,PW) do{ MF; sacc+=A0; sacc+=A1; sacc+=A2; sacc+=A3; PIN(sacc); W0; W1; PIN(PW); SBAR(); }while(0)
  #define EX(v) __builtin_amdgcn_exp2f(v)
  #define GAPB(MF,X,B) do{ MF; X[B]=EX(X[B]); X[B+1]=EX(X[B+1]); X[B+2]=EX(X[B+2]); X[B+3]=EX(X[B+3]); PIN(X); SBAR(); }while(0)
  #define VRD(i) do{ vlo[i]=vtr(vp_+(((i)>>2)*4096+((i)&3)*1024)); vhi[i]=vtr(vp_+(((i)>>2)*4096+((i)&3)*1024+512)); }while(0)
  #define KRD(G,j) do{ if(G){ kload2(kf,kp0+sl_next,j); SBAR(); } }while(0)
  #define STEP(C0,C1,P0,P1,t,GK,GV,GL) do{ SBAR(); \
    C0=__builtin_amdgcn_mfma_f32_32x32x16_bf16(kaug0,qaug,f32x16{},0,0,0); C1=__builtin_amdgcn_mfma_f32_32x32x16_bf16(kaug1,qaug,f32x16{},0,0,0); SBAR(); \
    const lds_cptr vp_=vp0+sl_prev; \
    VRD(0); SBAR(); float sacc=(P0[0]+P0[1]); \
    GAPA(C0=__builtin_amdgcn_mfma_f32_32x32x16_bf16(kf[0],qr[0],C0,0,0,0), P0[2],P0[3],P0[4],P0[5],     pw0[0]=PKW(P0,0), pw0[1]=PKW(P0,2), pw0); \
    VRD(4); SBAR(); GAPA(C1=__builtin_amdgcn_mfma_f32_32x32x16_bf16(kf[1],qr[0],C1,0,0,0), P0[6],P0[7],P0[8],P0[9],     pw0[2]=PKW(P0,4), pw0[3]=PKW(P0,6), pw0); \
    VRD(1); SBAR(); GAPA(C0=__builtin_amdgcn_mfma_f32_32x32x16_bf16(kf[2],qr[1],C0,0,0,0),   P0[10],P0[11],P0[12],P0[13], pw1[0]=PKW(P0,8), pw1[1]=PKW(P0,10), pw1); \
    VRD(5); SBAR(); GAPA(C1=__builtin_amdgcn_mfma_f32_32x32x16_bf16(kf[3],qr[1],C1,0,0,0),   P0[14],P0[15],P1[0],P1[1],   pw1[2]=PKW(P0,12),pw1[3]=PKW(P0,14), pw1); \
    VRD(2); SBAR(); GAPA(C0=__builtin_amdgcn_mfma_f32_32x32x16_bf16(kf[4],qr[2],C0,0,0,0),   P1[2],P1[3],P1[4],P1[5],     pw2[0]=PKW(P1,0), pw2[1]=PKW(P1,2), pw2); \
    VRD(6); SBAR(); GAPA(C1=__builtin_amdgcn_mfma_f32_32x32x16_bf16(kf[5],qr[2],C1,0,0,0),   P1[6],P1[7],P1[8],P1[9],     pw2[2]=PKW(P1,4), pw2[3]=PKW(P1,6), pw2); \
    VRD(3); SBAR(); GAPA(C0=__builtin_amdgcn_mfma_f32_32x32x16_bf16(kf[6],qr[3],C0,0,0,0),   P1[10],P1[11],P1[12],P1[13], pw3[0]=PKW(P1,8), pw3[1]=PKW(P1,10), pw3); \
    VRD(7); SBAR(); GAPA(C1=__builtin_amdgcn_mfma_f32_32x32x16_bf16(kf[7],qr[3],C1,0,0,0),   P1[14],P1[15],0.f,0.f,       pw3[2]=PKW(P1,12),pw3[3]=PKW(P1,14), pw3); \
    l_reg+=sacc; \
    if(GK){DMA_K((t)+3,sl_cur);} if(GV){DMA_V((t)+1,sl_next);} \
    CMASK(C0,C1,t); \
    { float a=MX3(C0[0],C0[1],C1[0]),b=MX3(C0[2],C0[3],C1[1]); a=MX3(a,C1[2],C1[3]); \
      _Pragma("unroll") for(int r=4;r<16;r+=4){a=MX3(a,C0[r],C0[r+1]);b=MX3(b,C0[r+2],C0[r+3]);a=MX3(a,C1[r],C1[r+1]);b=MX3(b,C1[r+2],C1[r+3]);} \
      float rm=__builtin_fmaxf(a,b); { auto rr=__builtin_amdgcn_permlane32_swap(__float_as_uint(rm),__float_as_uint(rm),false,false); rm=__builtin_fmaxf(__uint_as_float(rr[0]),__uint_as_float(rr[1])); } \
      resc=false; \
      if(__builtin_expect(__any(rm>(float)THRL),0)){ const float dl=__builtin_fmaxf(rm,0.f); mhat+=dl; \
        _Pragma("unroll") for(int r=0;r<16;++r){C0[r]-=dl;C1[r]-=dl;} \
        qaug=mk_qaug(-(bq+mhat),hi); \
        const float f=__builtin_amdgcn_exp2f(-dl); l_reg*=f; if(hi==0)wsf[r32]=f; resc=true; } } \
    SBAR(); \
    GAPB(o[0]=__builtin_amdgcn_mfma_f32_32x32x16_bf16(PAF(0),VFR(0),o[0],0,0,0), C0,0); \
    GAPB(o[1]=__builtin_amdgcn_mfma_f32_32x32x16_bf16(PAF(0),VFR(4),o[1],0,0,0), C0,4); \
    KRD(GL,0); GAPB(o[0]=__builtin_amdgcn_mfma_f32_32x32x16_bf16(PAF(1),VFR(1),o[0],0,0,0), C0,8); \
    KRD(GL,1); GAPB(o[1]=__builtin_amdgcn_mfma_f32_32x32x16_bf16(PAF(1),VFR(5),o[1],0,0,0), C0,12); \
    KRD(GL,2); GAPB(o[0]=__builtin_amdgcn_mfma_f32_32x32x16_bf16(PAF(2),VFR(2),o[0],0,0,0), C1,0); \
    KRD(GL,3); GAPB(o[1]=__builtin_amdgcn_mfma_f32_32x32x16_bf16(PAF(2),VFR(6),o[1],0,0,0), C1,4); \
    GAPB(o[0]=__builtin_amdgcn_mfma_f32_32x32x16_bf16(PAF(3),VFR(3),o[0],0,0,0), C1,8); \
    GAPB(o[1]=__builtin_amdgcn_mfma_f32_32x32x16_bf16(PAF(3),VFR(7),o[1],0,0,0), C1,12); \
    }while(0)
  int t=1;
  #undef CMASK
  #define CMASK(P0,P1,t) do{}while(0)
  for(;t+5<NT;t+=2){
    STEP(pB0,pB1,pA0,pA1,t,true,true,true);     KAUG(t+1); WAIT_BAR(2); RESC(); ROT();
    STEP(pA0,pA1,pB0,pB1,t+1,true,true,true);   KAUG(t+2); WAIT_BAR(2); RESC(); ROT();
  }
  #undef CMASK
  #define CMASK(P0,P1,t) do{int jb_=(t)-(NT-4); if(jb_>=0)cmask(P0,P1,jb_,qrel,hi);}while(0)
  #define ENDW(tt) do{ if((tt)+3<NT){WAIT_BAR(2);} else if((tt)+2<NT){WAIT_BAR(1);} else {WAIT_BAR(0);} }while(0)
  for(;t+1<NT;t+=2){
    STEP(pB0,pB1,pA0,pA1,t,(t+3<NT),(t+1<NT),(t+1<NT));       KAUG(t+1); ENDW(t);   RESC(); ROT();
    STEP(pA0,pA1,pB0,pB1,t+1,(t+4<NT),(t+2<NT),(t+2<NT));     KAUG(t+2); ENDW(t+1); RESC(); ROT();
  }
  STEP(pB0,pB1,pA0,pA1,NT-1,false,false,false); RESC();
  { float sacc=pB0[0]+pB0[1]; _Pragma("unroll") for(int r=2;r<16;++r)sacc+=pB0[r]; _Pragma("unroll") for(int r=0;r<16;++r)sacc+=pB1[r]; l_reg+=sacc;
    pw0=(u32x4){PKW(pB0,0),PKW(pB0,2),PKW(pB0,4),PKW(pB0,6)};pw1=(u32x4){PKW(pB0,8),PKW(pB0,10),PKW(pB0,12),PKW(pB0,14)};pw2=(u32x4){PKW(pB1,0),PKW(pB1,2),PKW(pB1,4),PKW(pB1,6)};pw3=(u32x4){PKW(pB1,8),PKW(pB1,10),PKW(pB1,12),PKW(pB1,14)};
    SBAR(); pv(o,vb0+sl_cur,PAF(0),PAF(1),PAF(2),PAF(3)); }
  #undef PKW
  #undef PAF
  #undef VFR
  #undef PIN
  #undef MX3
  #undef GAPA
  #undef GAPB
  #undef EX
  #undef VRD
  #undef KRD
  #undef STEP
  #undef ENDW
  {auto rr=__builtin_amdgcn_permlane32_swap(__float_as_uint(l_reg),__float_as_uint(l_reg),false,false);l_reg=__uint_as_float(rr[0])+__uint_as_float(rr[1]);}
  if(hi==0)wsf[32+r32]=l_reg;asm volatile("s_waitcnt lgkmcnt(0)":::"memory");
  float rli[16];
  #pragma unroll
  for(int r=0;r<16;++r)rli[r]=__builtin_amdgcn_rcpf(wsf[32+crow(r,hi)]);
  unsigned char*Ow=(unsigned char*)O+(rowbase+q0+wid*QBLK)*512+h*D;
  { unsigned char*stg=(unsigned char*)(shm+LDS_OST)+wid*2048;
    #pragma unroll
    for(int r=0;r<16;++r){const int orow=crow(r,hi);
      #pragma unroll
      for(int d0=0;d0<2;++d0){ const float y_=__builtin_amdgcn_fmed3f(o[d0][r]*rli[r]*16.0f,-440.f,440.f); stg[orow*64+d0*32+r32]=(unsigned char)(__builtin_amdgcn_cvt_pk_fp8_f32(y_,y_,0,false)&0xff); } }
    asm volatile("s_waitcnt lgkmcnt(0)":::"memory");
    #pragma unroll
    for(int i=0;i<2;++i){const int row=i*16+(lane>>2),ch=lane&3; const u32x4 v=*(const u32x4*)(stg+row*64+ch*16); ATTN_STORE16(Ow+(long)row*512+ch*16,v);} }
  asm volatile("s_waitcnt lgkmcnt(0)\n\ts_barrier":::"memory");
  #undef DMA_K
  #undef KAUG
  #undef DMA_V
  #undef CMASK
  #undef START
  #undef RESC
  #undef ROT
}
#undef SBAR
#undef WAIT_BAR
}
constexpr int NWAVES = 8;
constexpr int T = 32768, D = 1024, SEQ = 4096, DEPTH = 2, NIN = 5128;
constexpr int NSLOT = 9, MAXTILES = 1216;
constexpr float SLOT_SCALE = 16.0f;
constexpr float EPS = 1e-6f;
constexpr float C2 = 0.125f * 1.4426950408889634f;
constexpr size_t MiB = 1u << 20;
constexpr size_t WS_CTL = 0, CTL_ZERO_BYTES = 1 * MiB;
constexpr size_t WS_MOD = 1 * MiB;
constexpr size_t WS_GAIN = 1 * MiB + 512 * 1024;
constexpr size_t WS_LOGF = 2 * MiB;
constexpr size_t WS_CUM = 3 * MiB;
constexpr size_t WS_META = 6 * MiB;
constexpr size_t WS_WIN = 22 * MiB;
constexpr size_t WS_WING = 22 * MiB;
constexpr size_t WS_HQ = 575 * MiB;
constexpr size_t WS_WPROJ = 32 * MiB;
constexpr size_t WS_WOUT = 34 * MiB;
constexpr size_t WS_MQ = 236 * MiB;
constexpr float M_SCALE = 16.0f;
constexpr size_t WS_WR = 36 * MiB;
constexpr size_t WS_WGU = 37 * MiB;
constexpr size_t WS_WD = 102 * MiB;
constexpr int HP = 1088;
constexpr size_t WS_H = 135 * MiB;
constexpr size_t WS_H2 = 287 * MiB;
constexpr size_t WS_QKV = 204 * MiB;
constexpr size_t QKV_STRIDE = (size_t)T * 512;
constexpr size_t WS_G = 396 * MiB;
constexpr size_t G_STRIDE = (size_t)T * 1024;
constexpr size_t WS_H2Q = 352 * MiB;
constexpr float WGU_SCALE = 64.0f;
constexpr float ACT_SCALE = 8.0f;
constexpr size_t WS_ACT = 135 * MiB;
constexpr size_t WS_SLOT = 287 * MiB;
constexpr size_t WS_LTK = 575 * MiB, WS_LW = 583 * MiB;
constexpr int LCAP = 32768;
constexpr size_t WS_END = 607 * MiB;
static_assert(WS_SLOT + (size_t)T * NSLOT * 1024 <= WS_LTK && WS_ACT + (size_t)MAXTILES * 256 * 512 <= WS_H2 && WS_H2 + (size_t)(T + 256) * 2048 <= WS_LTK && WS_G + 2 * G_STRIDE * 2 <= WS_LTK && WS_QKV + 6 * QKV_STRIDE * 2 <= WS_G && WS_LW + (size_t)64 * LCAP * 4 <= WS_END, "ws map");
constexpr int CW_BAR = 4096, CW_GCNT = 8192;
constexpr int RING_BYTES = 131072, LDSCTL_OFF = RING_BYTES, MISC_OFF = LDSCTL_OFF + 320, LDS_BYTES = 147456;

#define GAS __attribute__((address_space(1)))
#define LAS __attribute__((address_space(3)))
typedef unsigned short bf16;
typedef unsigned v4u __attribute__((ext_vector_type(4)));
typedef unsigned v2u __attribute__((ext_vector_type(2)));
typedef float f32x4 __attribute__((ext_vector_type(4)));
__device__ __forceinline__ v4u pair16(v2u A, v2u B) { auto rx = __builtin_amdgcn_permlane16_swap(A.x, B.x, false, false); auto ry = __builtin_amdgcn_permlane16_swap(A.y, B.y, false, false); return (v4u){rx[0], ry[0], rx[1], ry[1]}; }
__device__ __forceinline__ void unpair16(v4u L, v2u& A, v2u& B) { auto rx = __builtin_amdgcn_permlane16_swap(L.x, L.z, false, false); auto ry = __builtin_amdgcn_permlane16_swap(L.y, L.w, false, false); A = (v2u){rx[0], ry[0]}; B = (v2u){rx[1], ry[1]}; }
#define LDS_WAIT() asm volatile("s_waitcnt lgkmcnt(0)" ::: "memory")
__device__ __forceinline__ unsigned f2bf(float f) { unsigned u = __builtin_bit_cast(unsigned, f); return (u + 0x7fffu + ((u >> 16) & 1u)) >> 16; }
__device__ __forceinline__ unsigned pk2(float lo, float hi) { return f2bf(lo) | (f2bf(hi) << 16); }
__device__ __forceinline__ float bflo(unsigned w) { return __uint_as_float(w << 16); }
__device__ __forceinline__ float bfhi(unsigned w) { return __uint_as_float(w & 0xffff0000u); }
__device__ __forceinline__ float sigmoidf_(float x) { return __builtin_amdgcn_rcpf(1.0f + __expf(-x)); }

#define XB_TMO      128
#define XB_XCNT(j)  (256  + 64 * (j))
#define XB_XSUB(j)  (1280 + 64 * (j))
#define XB_XGEN(j)  (2304 + 64 * (j))
#define XB_TOP      3328
#define XB_TOPGEN   3392
#define XCD_BAR_WORDS 3456
#define XB_SPIN_CAP (1u << 18)
__device__ __forceinline__ unsigned xb_ld(unsigned* p)              { return __hip_atomic_load(p, __ATOMIC_RELAXED, __HIP_MEMORY_SCOPE_AGENT); }
__device__ __forceinline__ unsigned xb_add(unsigned* p, unsigned v) { return __hip_atomic_fetch_add(p, v, __ATOMIC_RELAXED, __HIP_MEMORY_SCOPE_AGENT); }
__device__ __forceinline__ unsigned xb_xcc_id() { return (unsigned)__builtin_amdgcn_s_getreg((3 << 11) | 20) & 0xFu; }
#define XB_SPIN(cond, bar) do { unsigned _sp = 0; while (cond) {   \
    if ((++_sp & 255u) == 0u) { if (xb_ld(&(bar)[XB_TMO])) break; if (_sp > XB_SPIN_CAP) { atomicAdd(&(bar)[XB_TMO], 1u); break; } } } } while (0)
struct XcdBarrier { unsigned* bar; unsigned x; volatile LAS unsigned* st; };
__device__ __forceinline__ XcdBarrier xcd_barrier_post(unsigned* bar, volatile LAS unsigned* st) {
    XcdBarrier b; b.bar = bar; b.x = xb_xcc_id(); b.st = st;
    if (threadIdx.x == 0) (void)xb_add(&bar[XB_XCNT(b.x)], 1u);
    return b;
}
__device__ __forceinline__ void xcd_barrier_complete(unsigned* bar, unsigned x, unsigned& nloc, unsigned& nx) {
    const unsigned G = gridDim.x * gridDim.y * gridDim.z;
    unsigned sum, cnt, mine, sp = 0u;
    for (;;) {
        sum = 0u; cnt = 0u; mine = 0u;
#pragma unroll
        for (unsigned j = 0; j < 16; ++j) { const unsigned c = xb_ld(&bar[XB_XCNT(j)]); sum += c; cnt += (c > 0u) ? 1u : 0u; mine = (j == x) ? c : mine; }
        if (sum == G) break;
        __builtin_amdgcn_s_sleep(1);
        if ((++sp & 255u) == 0u) { if (xb_ld(&bar[XB_TMO])) break; if (sp > XB_SPIN_CAP) { atomicAdd(&bar[XB_TMO], 1u); break; } }
    }
    nloc = mine > 0u ? mine : 1u; nx = cnt > 0u ? cnt : 1u;
}
__device__ __forceinline__ void xcd_barrier(const XcdBarrier& b) {
    asm volatile("s_waitcnt vmcnt(0)" ::: "memory");
    __syncthreads();
    if (threadIdx.x == 0) {
        unsigned* bar = b.bar;
        __builtin_amdgcn_s_waitcnt(0);
        unsigned nloc = b.st[0], nx = b.st[1];
        if (nloc == 0u) { xcd_barrier_complete(bar, b.x, nloc, nx); b.st[0] = nloc; b.st[1] = nx; }
        const unsigned old = xb_add(&bar[XB_XSUB(b.x)], 1u);
        const unsigned gen = old / nloc;
        if (old + 1u == (gen + 1u) * nloc) {
            __builtin_amdgcn_fence(__ATOMIC_RELEASE, "agent");
            asm volatile("s_waitcnt vmcnt(0)" ::: "memory");
            const unsigned og = xb_add(&bar[XB_TOP], 1u);
            const unsigned tg = og / nx;
            __builtin_amdgcn_fence(__ATOMIC_ACQUIRE, "agent");
            if (og + 1u != (tg + 1u) * nx) XB_SPIN(xb_ld(&bar[XB_TOP]) < (tg + 1u) * nx, bar);
            __hip_atomic_store(&bar[XB_XGEN(b.x)], gen + 1u, __ATOMIC_RELAXED, __HIP_MEMORY_SCOPE_AGENT);
            asm volatile("s_waitcnt vmcnt(0)" ::: "memory");
        } else {
            __builtin_amdgcn_fence(__ATOMIC_ACQUIRE, "agent");
            XB_SPIN(xb_ld(&bar[XB_XGEN(b.x)]) == gen, bar);
            asm volatile("s_waitcnt vmcnt(0)" ::: "memory");
        }
    }
    __syncthreads();
}

__device__ __forceinline__ float wave_allsum(float x) {
#define WAS_DPP(ctrl) x += __int_as_float(__builtin_amdgcn_update_dpp(0, __float_as_int(x), ctrl, 0xf, 0xf, true))
    WAS_DPP(0xB1); WAS_DPP(0x4E); WAS_DPP(0x141); WAS_DPP(0x140);
#undef WAS_DPP
    { auto r16 = __builtin_amdgcn_permlane16_swap(__float_as_uint(x), __float_as_uint(x), false, false); x = __uint_as_float(r16[0]) + __uint_as_float(r16[1]); }
    { auto r32 = __builtin_amdgcn_permlane32_swap(__float_as_uint(x), __float_as_uint(x), false, false); x = __uint_as_float(r32[0]) + __uint_as_float(r32[1]); }
    return x;
}
__device__ __forceinline__ float wave_sum(float v) {
#pragma unroll
    for (int o = 1; o < 64; o <<= 1) v += __shfl_xor(v, o);
    return v;
}
template <bool PERMD = false, bool OUT8 = false>
__device__ __forceinline__ void transpose_item(const float* __restrict__ W, int ldw, int col0, int k0, bf16* WT, int ldt, int drow0, LAS float* scr, int lane) {
#pragma unroll 8
    for (int i = 0; i < 32; ++i) { const int kk = 2 * i + (lane >> 5); scr[kk * 33 + (lane & 31)] = W[(size_t)(k0 + kk) * ldw + col0 + (lane & 31)]; }
    LDS_WAIT(); asm volatile("" ::: "memory");
    const int c = lane & 7;
#pragma unroll
    for (int j = 0; j < 4; ++j) { const int n = (lane >> 3) + 8 * j; const LAS float* s = scr + (8 * c) * 33 + n;
        v4u o; o.x = pk2(s[0 * 33], s[1 * 33]); o.y = pk2(s[2 * 33], s[3 * 33]); o.z = pk2(s[4 * 33], s[5 * 33]); o.w = pk2(s[6 * 33], s[7 * 33]);
        const int nr = PERMD ? (128 * ((n >> 3) & 1) + 8 * (n >> 4) + (n & 7)) : n;
        if (OUT8) { int q0 = __builtin_amdgcn_cvt_pk_fp8_f32(s[0 * 33] * WGU_SCALE, s[1 * 33] * WGU_SCALE, 0, false); q0 = __builtin_amdgcn_cvt_pk_fp8_f32(s[2 * 33] * WGU_SCALE, s[3 * 33] * WGU_SCALE, q0, true);
            int q1 = __builtin_amdgcn_cvt_pk_fp8_f32(s[4 * 33] * WGU_SCALE, s[5 * 33] * WGU_SCALE, 0, false); q1 = __builtin_amdgcn_cvt_pk_fp8_f32(s[6 * 33] * WGU_SCALE, s[7 * 33] * WGU_SCALE, q1, true);
            v2u o8; o8.x = (unsigned)q0; o8.y = (unsigned)q1; *(v2u*)((unsigned char*)WT + (size_t)(drow0 + nr) * ldt + k0 + 8 * c) = o8; }
        else *(v4u*)(WT + (size_t)(drow0 + nr) * ldt + k0 + 8 * c) = o; }
    LDS_WAIT(); asm volatile("" ::: "memory");
}

struct Args { const float* in[24]; float* out; unsigned char* ws; };
struct ArgView {
    __device__ __forceinline__ const float* operator[](int k) const { asm volatile("" : "+s"(k)); return ((const float* const __attribute__((address_space(4)))*)__builtin_amdgcn_kernarg_segment_ptr())[k]; } };
struct ArgsV { ArgView in;
    __device__ __forceinline__ float* outp() const { return (float*)in[24]; }
    __device__ __forceinline__ unsigned char* wsp() const { return (unsigned char*)in[25]; } };

enum { I_X = 0, I_C, I_ADAW, I_ADAB, I_MIXG, I_WIN, I_BF, I_QNA, I_KNA, I_QNB, I_KNB, I_REL, I_WPA, I_WPB, I_WOUT, I_FFNG, I_WR, I_RB, I_WGE, I_WUE, I_WDE, I_WGS, I_WUS, I_WDS };

struct CvtItem { const float* src; unsigned char* dst; int ldw, ldt, drow0, k0; bool perm, out8; };
__device__ __forceinline__ void cvt_decode(const ArgsV& a, int l, int it, CvtItem& c) {
    constexpr int I_IN = 2560, I_PA = 256, I_PB = 256, I_OUT = 512, I_R = 32, I_GU = 65 * 256;
    unsigned char* ws = a.wsp();
    int r = it; c.perm = false; c.out8 = true;
    if (r < I_IN) { const int kb = r / 160, nb = r % 160, pn = nb >> 3, g = nb & 7, lc0 = 64 * (g & 3) + 32 * (g >> 2);
        const int zc0 = pn < 12 ? 256 * pn + lc0 : 3080 + 256 * (pn - 12) + lc0;
        c.ldw = NIN; c.k0 = 64 * kb; c.src = a.in[I_WIN] + (size_t)l * D * NIN + (size_t)c.k0 * NIN + zc0; c.dst = ws + WS_WING; c.ldt = 1024; c.drow0 = 256 * pn + 32 * g; return; }
    r -= I_IN;
    if (r < I_PA + I_PB) { const int second = r >= I_PA; const int r1 = second ? r - I_PA : r; const int kb = r1 / 32, nb = r1 % 32;
        c.ldw = 1024; c.k0 = 64 * kb; c.src = a.in[second ? I_WPB : I_WPA] + (size_t)l * 512 * 1024 + (size_t)c.k0 * 1024 + 32 * nb; c.dst = ws + WS_WPROJ; c.ldt = 512; c.drow0 = (second ? 1024 : 0) + 32 * nb; return; }
    r -= I_PA + I_PB;
    if (r < I_OUT) { const int kb = r / 32, nb = r % 32;
        c.ldw = 1024; c.k0 = 64 * kb; c.src = a.in[I_WOUT] + (size_t)l * 1024 * 1024 + (size_t)c.k0 * 1024 + 32 * nb; c.dst = ws + WS_WOUT; c.ldt = 1024; c.drow0 = 32 * nb; return; }
    r -= I_OUT;
    if (r < I_R) { const int kb = r / 2, nb = r % 2;
        c.ldw = 64; c.k0 = 64 * kb; c.src = a.in[I_WR] + (size_t)l * 1024 * 64 + (size_t)c.k0 * 64 + 32 * nb; c.dst = ws + WS_WR; c.ldt = 2048; c.drow0 = 32 * nb; c.out8 = false; return; }
    r -= I_R;
    if (r < I_GU) { const int e = r >> 8, r1 = r & 255, mat = r1 >> 7, r2 = r1 & 127, kb = r2 >> 3, nb = r2 & 7;
        const float* src = e < 64 ? a.in[mat ? I_WUE : I_WGE] + ((size_t)l * 64 + e) * 262144 : a.in[mat ? I_WUS : I_WGS] + (size_t)l * 262144;
        c.ldw = 256; c.k0 = 64 * kb; c.src = src + (size_t)c.k0 * 256 + 32 * nb; c.dst = ws + WS_WGU; c.ldt = 1024; c.drow0 = e * 512 + 256 * (nb >> 2) + 128 * mat + 32 * (nb & 3); return; }
    r -= I_GU;
    { const int e = r >> 7, r1 = r & 127, kb = r1 >> 5, nb = r1 & 31;
        const float* src = e < 64 ? a.in[I_WDE] + ((size_t)l * 64 + e) * 262144 : a.in[I_WDS] + (size_t)l * 262144;
        const int q = nb & 7;
        c.ldw = 1024; c.k0 = 64 * kb; c.src = src + (size_t)c.k0 * 1024 + 32 * nb; c.dst = ws + WS_WD; c.ldt = 256; c.drow0 = e * 1024 + 256 * (nb >> 3) + 32 * (q >> 1) + 16 * (q & 1); c.perm = true; }
}
__device__ __forceinline__ void cvt_load(const CvtItem& c, int lane, f32x4 (&t)[8]) {
    const float* q = c.src + (size_t)(lane >> 3) * c.ldw + 4 * (lane & 7);
#pragma unroll
    for (int i = 0; i < 8; ++i) t[i] = *(const f32x4*)(q + (size_t)(8 * i) * c.ldw);
}
__device__ __forceinline__ void cvt_store(const CvtItem& c, const f32x4 (&t)[8], LAS float* scr, int lane) {
    { LAS float* d = scr + (lane >> 3) * 33 + 4 * (lane & 7);
#pragma unroll
      for (int i = 0; i < 8; ++i) { d[(8 * i) * 33 + 0] = t[i].x; d[(8 * i) * 33 + 1] = t[i].y; d[(8 * i) * 33 + 2] = t[i].z; d[(8 * i) * 33 + 3] = t[i].w; } }
    LDS_WAIT(); asm volatile("" ::: "memory");
    const int cc = lane & 7;
#pragma unroll
    for (int j = 0; j < 4; ++j) { const int n = (lane >> 3) + 8 * j; const LAS float* s = scr + (8 * cc) * 33 + n;
        const int nr = c.perm ? (128 * ((n >> 3) & 1) + 8 * (n >> 4) + (n & 7)) : n;
        if (c.out8) { int q0 = __builtin_amdgcn_cvt_pk_fp8_f32(s[0 * 33] * WGU_SCALE, s[1 * 33] * WGU_SCALE, 0, false); q0 = __builtin_amdgcn_cvt_pk_fp8_f32(s[2 * 33] * WGU_SCALE, s[3 * 33] * WGU_SCALE, q0, true);
            int q1 = __builtin_amdgcn_cvt_pk_fp8_f32(s[4 * 33] * WGU_SCALE, s[5 * 33] * WGU_SCALE, 0, false); q1 = __builtin_amdgcn_cvt_pk_fp8_f32(s[6 * 33] * WGU_SCALE, s[7 * 33] * WGU_SCALE, q1, true);
            v2u o8; o8.x = (unsigned)q0; o8.y = (unsigned)q1; *(v2u*)(c.dst + (size_t)(c.drow0 + nr) * c.ldt + c.k0 + 8 * cc) = o8; }
        else { v4u o; o.x = pk2(s[0 * 33], s[1 * 33]); o.y = pk2(s[2 * 33], s[3 * 33]); o.z = pk2(s[4 * 33], s[5 * 33]); o.w = pk2(s[6 * 33], s[7 * 33]);
            *(v4u*)(c.dst + (size_t)(c.drow0 + nr) * c.ldt + 2 * (c.k0 + 8 * cc)) = o; } }
    LDS_WAIT(); asm volatile("" ::: "memory");
}
constexpr int CVT_NITEMS = 2560 + 256 + 256 + 512 + 32 + 65 * 256 + 65 * 128;
__device__ __forceinline__ void convert_weights(const ArgsV& a, int l, LAS unsigned char* lds, int gw, int NGW, int wave, int lane, int it_lo = 0, int it_hi = CVT_NITEMS) {
    LAS float* scr = (LAS float*)(lds + wave * 8448);
    const int NITEMS = it_hi;
    int it = it_lo + gw; if (it >= NITEMS) return;
    CvtItem cur; f32x4 tn[8];
    cvt_decode(a, l, it, cur); cvt_load(cur, lane, tn);
    for (;;) {
        f32x4 tc[8];
#pragma unroll
        for (int i = 0; i < 8; ++i) tc[i] = tn[i];
        const int itn = it + NGW; const bool more = itn < NITEMS; CvtItem nxt = cur;
        if (more) { cvt_decode(a, l, itn, nxt); cvt_load(nxt, lane, tn); }
        cvt_store(cur, tc, scr, lane);
        if (!more) break;
        cur = nxt; it = itn;
    }
}

__device__ __forceinline__ void mod_unit(const ArgsV& a, int u, LAS unsigned char* lds, int tid, int wave, int lane) {
    LAS float* cact = (LAS float*)(lds + 73728);
    LAS float* part = (LAS float*)(lds + 73728 + 32768);
    { const float* cin = a.in[I_C]; float cv[16];
#pragma unroll
      for (int k = 0; k < 16; ++k) cv[k] = cin[tid + 512 * k];
#pragma unroll
      for (int k = 0; k < 16; ++k) cact[tid + 512 * k] = cv[k] * sigmoidf_(cv[k]); }
    __syncthreads();
    const int l = u / 96, cg = u % 96;
    const float* W = a.in[I_ADAW] + (size_t)l * D * 6144 + 64 * cg + lane;
    float acc[8];
#pragma unroll
    for (int b = 0; b < 8; ++b) acc[b] = 0.f;
#pragma unroll 16
    for (int k = 128 * wave; k < 128 * wave + 128; ++k) { const float wv = W[(size_t)k * 6144];
#pragma unroll
        for (int b = 0; b < 8; ++b) acc[b] += cact[b * 1024 + k] * wv; }
#pragma unroll
    for (int b = 0; b < 8; ++b) part[(wave * 8 + b) * 64 + lane] = acc[b];
    __syncthreads();
    { const int b = tid >> 6; float s = 0.f;
#pragma unroll
      for (int w = 0; w < 8; ++w) s += part[(w * 8 + b) * 64 + lane];
      ((float*)(a.wsp() + WS_MOD))[(size_t)(l * 8 + b) * 6144 + 64 * cg + lane] = s + a.in[I_ADAB][l * 6144 + 64 * cg + lane]; }
    __syncthreads();
}

typedef float f32x2_ __attribute__((ext_vector_type(2)));
__device__ __forceinline__ void add_fp8x16(f32x4 (&s)[4], const v4u w) {
    const unsigned ww[4] = {w.x, w.y, w.z, w.w};
#pragma unroll
    for (int q = 0; q < 4; ++q) { const f32x2_ lo = __builtin_amdgcn_cvt_pk_f32_fp8((int)ww[q], false), hi = __builtin_amdgcn_cvt_pk_f32_fp8((int)ww[q], true); s[q].x += lo.x; s[q].y += lo.y; s[q].z += hi.x; s[q].w += hi.y; }
}
constexpr int XP = 2048;
__device__ __forceinline__ void xrow_load16(const bf16* xb, size_t m, int lane, f32x4 (&v)[4]) {
    const v4u w0 = *(const v4u*)(xb + m * XP + 16 * lane), w1 = *(const v4u*)(xb + m * XP + 16 * lane + 8);
    v[0] = (f32x4){bflo(w0.x), bfhi(w0.x), bflo(w0.y), bfhi(w0.y)}; v[1] = (f32x4){bflo(w0.z), bfhi(w0.z), bflo(w0.w), bfhi(w0.w)};
    v[2] = (f32x4){bflo(w1.x), bfhi(w1.x), bflo(w1.y), bfhi(w1.y)}; v[3] = (f32x4){bflo(w1.z), bfhi(w1.z), bflo(w1.w), bfhi(w1.w)}; }
__device__ __forceinline__ void xrow_store16(bf16* xb, size_t m, int lane, const f32x4 (&v)[4]) {
    v4u w0, w1; w0.x = pg8::cvt_pk_bf16(v[0].x, v[0].y); w0.y = pg8::cvt_pk_bf16(v[0].z, v[0].w); w0.z = pg8::cvt_pk_bf16(v[1].x, v[1].y); w0.w = pg8::cvt_pk_bf16(v[1].z, v[1].w);
    w1.x = pg8::cvt_pk_bf16(v[2].x, v[2].y); w1.y = pg8::cvt_pk_bf16(v[2].z, v[2].w); w1.z = pg8::cvt_pk_bf16(v[3].x, v[3].y); w1.w = pg8::cvt_pk_bf16(v[3].z, v[3].w);
    *(v4u*)(xb + m * XP + 16 * lane) = w0; *(v4u*)(xb + m * XP + 16 * lane + 8) = w1; }
__device__ __forceinline__ void reduce_rows(const ArgsV& a, int l, int row_lo, int row_hi, int gw, int NGW, int lane) {
    const float* mod = (const float*)(a.wsp() + WS_MOD);
    const unsigned char* slots = (const unsigned char*)(a.wsp() + WS_SLOT);
    for (int m = row_lo + gw; m < row_hi; m += NGW) {
        const int b = m >> 12;
        const float* g2 = mod + (size_t)(l * 8 + b) * 6144 + 5120 + 16 * lane;
        float* xr = a.outp() + (size_t)m * D + 16 * lane;
        f32x4 s[4], xv[4]; xrow_load16((const bf16*)a.outp(), (size_t)m, lane, xv);
#pragma unroll
        for (int q = 0; q < 4; ++q) s[q] = (f32x4){0.f, 0.f, 0.f, 0.f};
#pragma unroll
        for (int k = 0; k < NSLOT; ++k) add_fp8x16(s, *(const v4u*)(slots + ((size_t)m * NSLOT + k) * 1024 + 16 * lane));
#pragma unroll
        for (int q = 0; q < 4; ++q) { const f32x4 g = *(const f32x4*)(g2 + 4 * q); xv[q] = xv[q] + g * s[q] * (1.0f / SLOT_SCALE); }
        asm volatile("" ::: "memory");
#pragma unroll
        for (int q = 0; q < 4; ++q) *(f32x4*)(xr + 4 * q) = xv[q];
    }
}

constexpr int MF_GA = RING_BYTES + 1024, MF_GB = MF_GA + 4096, MF_RSTD = MF_GB + 4096;
static_assert(MF_RSTD + 512 <= LDS_BYTES, "MoE-front tables fit above the ring");
template <int WHICH, bool FOLD>
__device__ __forceinline__ void norm_rows(const ArgsV& a, int l, LAS unsigned char* lds, int gw, int lane) {
    constexpr int NR = 2;
    const float* mod = (const float*)(a.wsp() + WS_MOD);
    bf16* H = (bf16*)(a.wsp() + (WHICH == 0 ? WS_H : WS_H2));
    const LAS float* wfl = (const LAS float*)(lds + 73728);
    const int m0 = 16 * gw, b = m0 >> 12;
    const float* gsrc = a.in[WHICH == 0 ? I_MIXG : I_FFNG] + l * D;
    const float* sh = mod + (size_t)(l * 8 + b) * 6144 + (WHICH == 0 ? 0 : 3072);
    const float* sc = sh + 1024;
    constexpr bool fold = FOLD;
    constexpr bool XB = FOLD || WHICH == 1;
    const int cb = XB ? 16 * lane : 4 * lane, cs = XB ? 4 : 256;
    f32x4 gA[4], gB[4];
#pragma unroll
    for (int jj = 0; jj < 4; ++jj) { const int c = cb + cs * jj; const f32x4 g = *(const f32x4*)(gsrc + c), s = *(const f32x4*)(sc + c); gA[jj] = g * (s + 1.0f); gB[jj] = *(const f32x4*)(sh + c); }
    const float* xsrc = a.in[I_X]; bf16* xb = (bf16*)a.outp();
    v4u xraw[NR][2];
    constexpr bool PFX = XB && !FOLD;
    if constexpr (PFX) {
#pragma unroll
        for (int r = 0; r < NR; ++r) { xraw[r][0] = *(const v4u*)(xb + (size_t)(m0 + r) * XP + 16 * lane); xraw[r][1] = *(const v4u*)(xb + (size_t)(m0 + r) * XP + 16 * lane + 8); } }
#pragma unroll 1
    for (int rq = 0; rq < 16 / NR; ++rq) { const int mb = m0 + NR * rq;
        f32x4 v[NR][4];
#pragma unroll
        for (int r = 0; r < NR; ++r) {
            if constexpr (XB && !PFX) xrow_load16(xb, (size_t)(mb + r), lane, v[r]);
            else if constexpr (PFX) { const v4u w0 = xraw[r][0], w1 = xraw[r][1];
                v[r][0] = (f32x4){bflo(w0.x), bfhi(w0.x), bflo(w0.y), bfhi(w0.y)}; v[r][1] = (f32x4){bflo(w0.z), bfhi(w0.z), bflo(w0.w), bfhi(w0.w)};
                v[r][2] = (f32x4){bflo(w1.x), bfhi(w1.x), bflo(w1.y), bfhi(w1.y)}; v[r][3] = (f32x4){bflo(w1.z), bfhi(w1.z), bflo(w1.w), bfhi(w1.w)};
                const int mn = (rq + 1 < 16 / NR) ? mb + NR : mb;
                xraw[r][0] = *(const v4u*)(xb + (size_t)(mn + r) * XP + 16 * lane); xraw[r][1] = *(const v4u*)(xb + (size_t)(mn + r) * XP + 16 * lane + 8); }
            else {
#pragma unroll
                for (int jj = 0; jj < 4; ++jj) v[r][jj] = *(const f32x4*)(xsrc + (size_t)(mb + r) * D + cb + cs * jj); } }
        if (fold) {
            const unsigned char* slots = (const unsigned char*)(a.wsp() + WS_SLOT); const float* g2 = mod + (size_t)((l - 1) * 8 + b) * 6144 + 5120 + 16 * lane;
#pragma unroll
            for (int r = 0; r < NR; ++r) { f32x4 s[4];
#pragma unroll
                for (int q = 0; q < 4; ++q) s[q] = (f32x4){0.f, 0.f, 0.f, 0.f};
#pragma unroll
                for (int k = 0; k < NSLOT; ++k) add_fp8x16(s, *(const v4u*)(slots + ((size_t)(mb + r) * NSLOT + k) * 1024 + 16 * lane));
#pragma unroll
                for (int jj = 0; jj < 4; ++jj) v[r][jj] = v[r][jj] + *(const f32x4*)(g2 + 4 * jj) * s[jj] * (1.0f / SLOT_SCALE);
                xrow_store16(xb, (size_t)(mb + r), lane, v[r]);
                asm volatile("" ::: "memory"); }
        }
        float ss[NR];
#pragma unroll
        for (int r = 0; r < NR; ++r) { ss[r] = 0.f;
#pragma unroll
            for (int jj = 0; jj < 4; ++jj) ss[r] += (v[r][jj].x * v[r][jj].x + v[r][jj].y * v[r][jj].y) + (v[r][jj].z * v[r][jj].z + v[r][jj].w * v[r][jj].w); }
#pragma unroll
        for (int r = 0; r < NR; ++r) ss[r] = wave_allsum(ss[r]);
#pragma unroll
        for (int r = 0; r < NR; ++r) { const float rstd = __builtin_amdgcn_rsqf(ss[r] * (1.0f / D) + EPS);
            if (WHICH == 1 && lane == 0) ((LAS float*)(lds + MF_RSTD))[(gw & 7) * 16 + NR * rq + r] = rstd;
            unsigned qv[4];
#pragma unroll
            for (int jj = 0; jj < 4; ++jj) { v[r][jj] = v[r][jj] * rstd * gA[jj] + gB[jj];
                int q = __builtin_amdgcn_cvt_pk_fp8_f32(v[r][jj].x, v[r][jj].y, 0, false); q = __builtin_amdgcn_cvt_pk_fp8_f32(v[r][jj].z, v[r][jj].w, q, true); qv[jj] = (unsigned)q; }
            unsigned char* const hrow = a.wsp() + (WHICH == 1 ? WS_H2Q : WS_HQ) + (size_t)(mb + r) * D;
            if constexpr (XB) *(v4u*)(hrow + 16 * lane) = (v4u){qv[0], qv[1], qv[2], qv[3]};
            else {
#pragma unroll
                for (int jj = 0; jj < 4; ++jj) *(unsigned*)(hrow + cb + cs * jj) = qv[jj]; } }
        if (WHICH == 0) {
            float fv[8 * NR];
#pragma unroll
            for (int i = 0; i < 8 * NR; ++i) fv[i] = 0.f;
#pragma unroll
            for (int j = 0; j < 8; ++j) {
#pragma unroll
                for (int jj = 0; jj < 4; ++jj) { const f32x4 w = *(const LAS f32x4*)(wfl + j * 1024 + cb + cs * jj);
#pragma unroll
                    for (int r = 0; r < NR; ++r) fv[r * 8 + j] += (v[r][jj].x * w.x + v[r][jj].y * w.y) + (v[r][jj].z * w.z + v[r][jj].w * w.w); }
                if (j & 1) asm volatile("" ::: "memory"); }
            constexpr int NST = (NR == 4) ? 5 : 4;
#pragma unroll
            for (int s = 0; s < NST; ++s) { const bool bit = (lane >> s) & 1;
#pragma unroll
                for (int j = 0; j < ((4 * NR) >> s); ++j) { const float lo = fv[2 * j], hi = fv[2 * j + 1]; const float snd = bit ? lo : hi, kp = bit ? hi : lo; fv[j] = kp + __shfl_xor(snd, 1 << s); } }
            float f = fv[0];
            if (NR == 2) f += __shfl_xor(f, 16);
            f += __shfl_xor(f, 32);
            if (lane < 8 * NR) { const int r = lane >> 3, j = lane & 7; f += a.in[I_BF][l * 8 + j];
                const float ls = fminf(f, 0.f) - log1pf(__expf(-fabsf(f)));
                ((float*)(a.wsp() + WS_LOGF))[(size_t)(b * 8 + j) * SEQ + ((mb + r) & (SEQ - 1))] = ls; }
        }
    }
}

__device__ __forceinline__ void route_block(const ArgsV& a, int l, int blk, LAS unsigned char* lds, const LAS float* lg, int tid) {
    LAS int* cntl = (LAS int*)(lds + 34816); LAS int* basel = (LAS int*)(lds + 34816 + 256);
    if (tid < 64) cntl[tid] = 0;
    __syncthreads();
    const int tkl = tid >> 2, part = tid & 3;
    int idx[8]; float wv[8]; int myrk0 = 0, myrk1 = 0;
    {
        const float* rb = a.in[I_RB] + l * 64 + 16 * part;
        float sc[16], bs[16];
#pragma unroll
        for (int q = 0; q < 4; ++q) { const f32x4 bb = *(const f32x4*)(rb + 4 * q);
#pragma unroll
            for (int i = 0; i < 4; ++i) { const float v = lg[tkl * 65 + 16 * part + 4 * q + i]; sc[4 * q + i] = sigmoidf_(v); bs[4 * q + i] = sc[4 * q + i] + bb[i]; } }
        float gl[2];
#pragma unroll
        for (int g = 0; g < 2; ++g) { float m1 = -INFINITY, m2 = -INFINITY;
#pragma unroll
            for (int jj = 0; jj < 8; ++jj) { const float v = bs[8 * g + jj]; if (v > m1) { m2 = m1; m1 = v; } else if (v > m2) { m2 = v; } }
            gl[g] = m1 + m2; }
        float gs[8];
#pragma unroll
        for (int q = 0; q < 4; ++q) { gs[2 * q] = __shfl(gl[0], (tid & ~3) + q); gs[2 * q + 1] = __shfl(gl[1], (tid & ~3) + q); }
        unsigned gmask = 0u;
#pragma unroll
        for (int p = 0; p < 4; ++p) { float best = -INFINITY; int bi = 0;
#pragma unroll
            for (int g = 0; g < 8; ++g) { const bool ok = !((gmask >> g) & 1u) && gs[g] > best; best = ok ? gs[g] : best; bi = ok ? g : bi; }
            gmask |= 1u << bi; }
#pragma unroll
        for (int e = 0; e < 16; ++e) bs[e] = ((gmask >> (2 * part + (e >> 3))) & 1u) ? bs[e] : -INFINITY;
        float wsum = 0.f;
#pragma unroll
        for (int p = 0; p < 8; ++p) { float best = -INFINITY; int bi = 16 * part; float bsc = 0.f;
#pragma unroll
            for (int e = 0; e < 16; ++e) { const bool ok = bs[e] > best; best = ok ? bs[e] : best; bi = ok ? 16 * part + e : bi; bsc = ok ? sc[e] : bsc; }
#pragma unroll
            for (int st = 1; st < 4; st <<= 1) { const float ov = __shfl_xor(best, st), os = __shfl_xor(bsc, st); const int oi = __shfl_xor(bi, st);
                const bool take = (ov > best) || (ov == best && oi < bi); best = take ? ov : best; bi = take ? oi : bi; bsc = take ? os : bsc; }
#pragma unroll
            for (int e = 0; e < 16; ++e) bs[e] = (16 * part + e == bi) ? -INFINITY : bs[e];
            idx[p] = bi; wv[p] = bsc; wsum += bsc; }
        const float scale = 2.5f / wsum;
#pragma unroll
        for (int p = 0; p < 8; ++p) { wv[p] *= scale;
            if ((p & 3) == part) { const int r_ = __hip_atomic_fetch_add(&cntl[idx[p]], 1, __ATOMIC_RELAXED, __HIP_MEMORY_SCOPE_WORKGROUP); if (p < 4) myrk0 = r_; else myrk1 = r_; } }
    }
    __syncthreads();
    if (tid < 64) basel[tid] = (int)__hip_atomic_fetch_add((unsigned*)(a.wsp() + WS_CTL) + CW_GCNT + l * 64 + tid, (unsigned)cntl[tid], __ATOMIC_RELAXED, __HIP_MEMORY_SCOPE_AGENT);
    __syncthreads();
    {
        const int tok = blk * 128 + tkl;
        int* ltk = (int*)(a.wsp() + WS_LTK); float* lw = (float*)(a.wsp() + WS_LW);
#pragma unroll
        for (int p = 0; p < 8; ++p) if ((p & 3) == part) { const int e = idx[p]; const size_t o = (size_t)e * LCAP + basel[e] + (p < 4 ? myrk0 : myrk1); ltk[o] = tok | (p << 16); lw[o] = wv[p]; }
    }
    __syncthreads();
}

typedef short bf16x8v __attribute__((ext_vector_type(8)));
__device__ __forceinline__ void moe_front(const ArgsV& a, int l, int blk, LAS unsigned char* lds, int tid, int wave, int lane) {
    { const bf16* wr = (const bf16*)(a.wsp() + WS_WR);
      v4u wt[16];
#pragma unroll
      for (int i = 0; i < 16; ++i) { const int idx = tid + 512 * i, row = idx >> 7, ch = idx & 127; wt[i] = *(const v4u*)(wr + (size_t)row * 1024 + ch * 8); }
#pragma unroll
      for (int i = 0; i < 16; ++i) { const int idx = tid + 512 * i, row = idx >> 7, ch = idx & 127; *(LAS v4u*)(lds + row * 2048 + ((ch ^ (row & 15)) * 16)) = wt[i]; } }
    { const int b = (blk * 128) >> 12; const float* mod = (const float*)(a.wsp() + WS_MOD); const float* sh = mod + (size_t)(l * 8 + b) * 6144 + 3072; const float* sc = sh + 1024; const float* gsrc = a.in[I_FFNG] + l * D;
      for (int c = tid; c < 1024; c += 512) { ((LAS float*)(lds + MF_GA))[c] = gsrc[c] * (sc[c] + 1.0f); ((LAS float*)(lds + MF_GB))[c] = sh[c]; } }
    norm_rows<1, false>(a, l, lds, blk * 8 + wave, lane);
    __syncthreads();
    const int fr = lane & 15, fq = lane >> 4;
    const bf16* arow = (const bf16*)a.outp() + (size_t)(blk * 128 + wave * 16 + fr) * XP + 8 * fq;
    const float rs_ = ((const LAS float*)(lds + MF_RSTD))[wave * 16 + fr];
    const LAS float* gAl = (const LAS float*)(lds + MF_GA) + 8 * fq; const LAS float* gBl = (const LAS float*)(lds + MF_GB) + 8 * fq;
    const LAS unsigned char* brow = lds + fr * 2048;
    pg8::f32x4 acc[4];
#pragma unroll
    for (int cb = 0; cb < 4; ++cb) acc[cb] = (pg8::f32x4){0.f, 0.f, 0.f, 0.f};
#pragma unroll 1
    for (int s0 = 0; s0 < 32; s0 += 8) { bf16x8v af[8]; v4u xr_[8];
#pragma unroll
        for (int s = 0; s < 8; ++s) xr_[s] = *(const v4u*)(arow + 32 * (s0 + s));
#pragma unroll
        for (int s = 0; s < 8; ++s) { const f32x4 ga0 = *(const LAS f32x4*)(gAl + 32 * (s0 + s)), ga1 = *(const LAS f32x4*)(gAl + 32 * (s0 + s) + 4), gb0 = *(const LAS f32x4*)(gBl + 32 * (s0 + s)), gb1 = *(const LAS f32x4*)(gBl + 32 * (s0 + s) + 4);
            const v4u w = xr_[s]; const f32x4 x0 = (f32x4){bflo(w.x), bfhi(w.x), bflo(w.y), bfhi(w.y)}, x1 = (f32x4){bflo(w.z), bfhi(w.z), bflo(w.w), bfhi(w.w)};
            const f32x4 h0 = x0 * rs_ * ga0 + gb0, h1 = x1 * rs_ * ga1 + gb1;
            v4u o; o.x = pg8::cvt_pk_bf16(h0.x, h0.y); o.y = pg8::cvt_pk_bf16(h0.z, h0.w); o.z = pg8::cvt_pk_bf16(h1.x, h1.y); o.w = pg8::cvt_pk_bf16(h1.z, h1.w); af[s] = __builtin_bit_cast(bf16x8v, o); }
#pragma unroll
        for (int s = 0; s < 8; s += 2) { bf16x8v bq[2][4];
#pragma unroll
            for (int s2 = 0; s2 < 2; ++s2)
#pragma unroll
                for (int cb = 0; cb < 4; ++cb) bq[s2][cb] = *(const LAS bf16x8v*)(brow + cb * 16 * 2048 + (((4 * (s0 + s + s2) + fq) ^ fr) * 16));
            __builtin_amdgcn_sched_barrier(0);
#pragma unroll
            for (int s2 = 0; s2 < 2; ++s2)
#pragma unroll
                for (int cb = 0; cb < 4; ++cb) acc[cb] = __builtin_amdgcn_mfma_f32_16x16x32_bf16(af[s + s2], bq[s2][cb], acc[cb], 0, 0, 0);
            __builtin_amdgcn_sched_barrier(0); } }
    __syncthreads();
    LAS float* lg = (LAS float*)lds;
#pragma unroll
    for (int cb = 0; cb < 4; ++cb)
#pragma unroll
        for (int r = 0; r < 4; ++r) lg[(wave * 16 + 4 * fq + r) * 65 + 16 * cb + fr] = acc[cb][r];
    __syncthreads();
    route_block(a, l, blk, lds, lg, tid);
}

constexpr int TAB_OFF = RING_BYTES + 1024, TAB_CNT = 0, TAB_TS = 80, TAB_TE = 160, TAB_TJ = 160 + MAXTILES;
static_assert(TAB_OFF + (TAB_TJ + MAXTILES) * 4 <= LDS_BYTES, "tile table fits above the ring");
__device__ __forceinline__ int moe_table(const ArgsV& a, int l, LAS unsigned char* lds, int tid) {
    LAS int* tab = (LAS int*)(lds + TAB_OFF);
    __syncthreads();
    if (tid < 64) {
        const int cnt = (int)((const unsigned*)(a.wsp() + WS_CTL))[CW_GCNT + l * 64 + tid]; tab[TAB_CNT + tid] = cnt;
        const int nt_ = (cnt + 255) >> 8; int inc = nt_;
#pragma unroll
        for (int o = 1; o < 64; o <<= 1) { const int v_ = __shfl_up(inc, o); if (tid >= o) inc += v_; }
        tab[TAB_TS + tid] = inc - nt_;
        if (tid == 63) { tab[TAB_TS + 64] = inc; tab[TAB_TS + 65] = inc + T / 256; tab[TAB_CNT + 64] = T; } }
    __syncthreads();
    const int ntl = tab[TAB_TS + 65];
    for (int t = tid; t < ntl; t += 512) { int e = 0;
        for (int q = 1; q < 65; ++q) e = (t >= tab[TAB_TS + q]) ? q : e;
        tab[TAB_TE + t] = e; tab[TAB_TJ + t] = t - tab[TAB_TS + e]; }
    __syncthreads();
    return ntl;
}

struct SchedDense { static constexpr bool EARLY_VOFF = false; pg8::TileOrder o; unsigned rowbytes; int pn_map;
    __device__ __forceinline__ bool next(int i, pg8::Unit& u) const { int pm, pn; if (!o.get(i, pm, pn)) return false; u.pm = pm; u.bt = pn; u.aux = 0;
        u.pn = pn_map == 0 ? pn : pn_map == 1 ? (pn < 4 ? pn : pn + 2) : (pn < 2 ? pn + 4 : pn + 8); return true; }
    __device__ __forceinline__ unsigned a_off(const pg8::Unit& u, int r) const { return (unsigned)(u.pm * 256 + r) * rowbytes; } };
struct SchedProj { static constexpr bool EARLY_VOFF = false; pg8::TileOrder o; unsigned rowbytes, delta;
    __device__ __forceinline__ bool next(int i, pg8::Unit& u) const { int pm, pn; if (!o.get(i >> 1, pm, pn)) return false; u.pm = pm; u.pn = pn; u.aux = i & 1; u.bt = (i & 1) * 4 + pn; return true; }
    __device__ __forceinline__ unsigned a_off(const pg8::Unit& u, int r) const { return (unsigned)u.aux * delta + (unsigned)(u.pm * 256 + r) * rowbytes; } };

struct EpiIn { static constexpr int NST = 16; static constexpr int ID = 0; static constexpr bool PREFETCH = false; static constexpr bool PERM = true;
    bf16* qkv; unsigned char* gates; const float* gains;
    __device__ __forceinline__ void operator()(const pg8::f32x4 (&acc)[2][2][4][2], const pg8::Unit& u, int wr, int wc, int fr, int fq) const {
        const int pn = u.pn, row0 = u.pm * 256 + wr * 64 + fr;
        if (pn < 12) {
            const int buf = pn >> 1, kind = buf % 3;
            bf16* out = qkv + (size_t)buf * QKV_STRIDE; const int colbase = 256 * (pn & 1) + 64 * wc + 8 * fq;
            const float* gp = gains + ((buf < 3 ? 0 : 2) + (kind & 1)) * 64;
            f32x4 gv[2][2];
#pragma unroll
            for (int bj = 0; bj < 2; ++bj)
#pragma unroll
                for (int n = 0; n < 2; ++n) gv[bj][n] = (kind < 2) ? *(const f32x4*)(gp + 32 * bj + 8 * fq + 4 * n) : (f32x4){1.f, 1.f, 1.f, 1.f};
#pragma unroll
            for (int ai = 0; ai < 2; ++ai)
#pragma unroll
                for (int m = 0; m < 4; ++m) { const int row = row0 + ai * 128 + m * 16; float rs = 1.0f;
                    if (kind < 2) { float ss = 0.f;
#pragma unroll
                        for (int bj = 0; bj < 2; ++bj)
#pragma unroll
                            for (int n = 0; n < 2; ++n) { const f32x4 x = acc[ai][bj][m][n]; ss += (x.x * x.x + x.y * x.y) + (x.z * x.z + x.w * x.w); }
                        { auto r16 = __builtin_amdgcn_permlane16_swap(__float_as_uint(ss), __float_as_uint(ss), false, false); ss = __uint_as_float(r16[0]) + __uint_as_float(r16[1]);
                          auto r32 = __builtin_amdgcn_permlane32_swap(__float_as_uint(ss), __float_as_uint(ss), false, false); ss = __uint_as_float(r32[0]) + __uint_as_float(r32[1]); }
                        rs = __builtin_amdgcn_rsqf(ss * (1.0f / 64.0f) + EPS * (WGU_SCALE * WGU_SCALE)); if (kind == 0) rs *= C2; }
                    else rs = 1.0f / WGU_SCALE;
#pragma unroll
                    for (int bj = 0; bj < 2; ++bj) { const f32x4 v0 = acc[ai][bj][m][0] * rs * gv[bj][0], v1 = acc[ai][bj][m][1] * rs * gv[bj][1];
                        v4u w; w.x = pg8::cvt_pk_bf16(v0.x, v0.y); w.y = pg8::cvt_pk_bf16(v0.z, v0.w); w.z = pg8::cvt_pk_bf16(v1.x, v1.y); w.w = pg8::cvt_pk_bf16(v1.z, v1.w);
                        *(v4u*)(out + (size_t)row * 512 + colbase + 32 * bj) = w; } }
        } else {
            unsigned char* out = gates + (size_t)((pn - 12) >> 2) * G_STRIDE; const int colbase = 256 * ((pn - 12) & 3) + 64 * wc + ((fq & 1) ? 32 + 8 * (fq - 1) : 8 * fq);
#pragma unroll
            for (int ai = 0; ai < 2; ++ai)
#pragma unroll
                for (int m = 0; m < 4; ++m) { const int row = row0 + ai * 128 + m * 16; v2u wq[2];
#pragma unroll
                    for (int bj = 0; bj < 2; ++bj) { const f32x4 a0 = acc[ai][bj][m][0], a1 = acc[ai][bj][m][1];
#define sigmoidf_(x) __builtin_amdgcn_rcpf((1.0f / 255.0f) + __builtin_amdgcn_exp2f(__builtin_fmaf((x), -1.4426950408889634f / WGU_SCALE, -7.994353436858858f)))
                        unsigned q0 = __builtin_amdgcn_cvt_pk_u8_f32(sigmoidf_(a0.x), 0, 0u); q0 = __builtin_amdgcn_cvt_pk_u8_f32(sigmoidf_(a0.y), 1, q0); q0 = __builtin_amdgcn_cvt_pk_u8_f32(sigmoidf_(a0.z), 2, q0); q0 = __builtin_amdgcn_cvt_pk_u8_f32(sigmoidf_(a0.w), 3, q0);
                        unsigned q1 = __builtin_amdgcn_cvt_pk_u8_f32(sigmoidf_(a1.x), 0, 0u); q1 = __builtin_amdgcn_cvt_pk_u8_f32(sigmoidf_(a1.y), 1, q1); q1 = __builtin_amdgcn_cvt_pk_u8_f32(sigmoidf_(a1.z), 2, q1); q1 = __builtin_amdgcn_cvt_pk_u8_f32(sigmoidf_(a1.w), 3, q1);
#undef sigmoidf_
                        wq[bj].x = q0; wq[bj].y = q1; }
                    *(v4u*)(out + (size_t)row * 1024 + colbase) = pair16(wq[0], wq[1]); }
        }
    } };
#define U8F(w, k) ((float)(((w) >> (8 * (k))) & 0xffu))
struct EpiProj { static constexpr int NST = 16; static constexpr int ID = 1; static constexpr bool PREFETCH = false; static constexpr bool PERM = true;
    const unsigned char* gates; unsigned char* M; unsigned char* MQ;
    __device__ __forceinline__ void operator()(pg8::f32x4 (&acc)[2][2][4][2], const pg8::Unit& u, int wr, int wc, int fr, int fq) const {
        const int pass = u.aux; const unsigned char* g = gates + (size_t)pass * G_STRIDE;
        const size_t row0 = (size_t)(u.pm * 256 + wr * 64 + fr) * 1024 + u.pn * 256 + wc * 32 + ((fq & 1) ? 128 + 8 * (fq - 1) : 8 * fq);
        if (pass == 0) {
            v4u gl[8];
#pragma unroll
            for (int gi = 0; gi < 8; ++gi) gl[gi] = *(const v4u*)(g + row0 + (size_t)((gi >> 2) * 128 + (gi & 3) * 16) * 1024);
#pragma unroll
            for (int gi = 0; gi < 8; ++gi) { const int ai = gi >> 2, m = gi & 3; const size_t ro = row0 + (size_t)(ai * 128 + m * 16) * 1024;
                v2u ga2[2], wq[2]; unpair16(gl[gi], ga2[0], ga2[1]);
#pragma unroll
                for (int bj = 0; bj < 2; ++bj) { const v2u gw_ = ga2[bj]; const f32x4 a0 = acc[ai][bj][m][0] * (M_SCALE / (255.0f * 16.0f * WGU_SCALE)), a1 = acc[ai][bj][m][1] * (M_SCALE / (255.0f * 16.0f * WGU_SCALE));
                    const float c0 = __builtin_amdgcn_fmed3f(U8F(gw_.x, 0) * a0.x, -440.f, 440.f), c1 = __builtin_amdgcn_fmed3f(U8F(gw_.x, 1) * a0.y, -440.f, 440.f), c2 = __builtin_amdgcn_fmed3f(U8F(gw_.x, 2) * a0.z, -440.f, 440.f), c3 = __builtin_amdgcn_fmed3f(U8F(gw_.x, 3) * a0.w, -440.f, 440.f),
                                c4 = __builtin_amdgcn_fmed3f(U8F(gw_.y, 0) * a1.x, -440.f, 440.f), c5 = __builtin_amdgcn_fmed3f(U8F(gw_.y, 1) * a1.y, -440.f, 440.f), c6 = __builtin_amdgcn_fmed3f(U8F(gw_.y, 2) * a1.z, -440.f, 440.f), c7 = __builtin_amdgcn_fmed3f(U8F(gw_.y, 3) * a1.w, -440.f, 440.f);
                    int q0 = __builtin_amdgcn_cvt_pk_fp8_f32(c0, c1, 0, false); q0 = __builtin_amdgcn_cvt_pk_fp8_f32(c2, c3, q0, true); int q1 = __builtin_amdgcn_cvt_pk_fp8_f32(c4, c5, 0, false); q1 = __builtin_amdgcn_cvt_pk_fp8_f32(c6, c7, q1, true);
                    wq[bj].x = (unsigned)q0; wq[bj].y = (unsigned)q1; }
                *(v4u*)(M + ro) = pair16(wq[0], wq[1]); }
            return; }
        v4u gbl[8], mbl[8];
#define EPROJ_LOAD(gi, buf) do { const size_t ro_ = row0 + (size_t)(((gi) >> 2) * 128 + ((gi) & 3) * 16) * 1024; gbl[buf] = *(const v4u*)(g + ro_); mbl[buf] = *(const v4u*)(M + ro_); } while (0)
#pragma unroll
        for (int gi = 0; gi < 8; ++gi) EPROJ_LOAD(gi, gi);
#pragma unroll
        for (int gi = 0; gi < 8; ++gi) { const int ai = gi >> 2, m = gi & 3, cb = gi;
            const size_t ro = row0 + (size_t)(ai * 128 + m * 16) * 1024;
            v2u gb2[2], mb2[2], wq[2]; unpair16(gbl[cb], gb2[0], gb2[1]); unpair16(mbl[cb], mb2[0], mb2[1]);
#pragma unroll
            for (int bj = 0; bj < 2; ++bj) { const v2u gw_ = gb2[bj]; const v2u p = mb2[bj]; const f32x4 a0 = acc[ai][bj][m][0] * (M_SCALE / (255.0f * 16.0f * WGU_SCALE)), a1 = acc[ai][bj][m][1] * (M_SCALE / (255.0f * 16.0f * WGU_SCALE));
                const f32x2_ p01 = __builtin_amdgcn_cvt_pk_f32_fp8((int)p.x, false), p23 = __builtin_amdgcn_cvt_pk_f32_fp8((int)p.x, true), p45 = __builtin_amdgcn_cvt_pk_f32_fp8((int)p.y, false), p67 = __builtin_amdgcn_cvt_pk_f32_fp8((int)p.y, true);
                const float r0 = U8F(gw_.x, 0) * a0.x + p01.x, r1 = U8F(gw_.x, 1) * a0.y + p01.y, r2 = U8F(gw_.x, 2) * a0.z + p23.x, r3 = U8F(gw_.x, 3) * a0.w + p23.y,
                            r4 = U8F(gw_.y, 0) * a1.x + p45.x, r5 = U8F(gw_.y, 1) * a1.y + p45.y, r6 = U8F(gw_.y, 2) * a1.z + p67.x, r7 = U8F(gw_.y, 3) * a1.w + p67.y;
                const float c0 = __builtin_amdgcn_fmed3f(r0, -440.f, 440.f), c1 = __builtin_amdgcn_fmed3f(r1, -440.f, 440.f), c2 = __builtin_amdgcn_fmed3f(r2, -440.f, 440.f), c3 = __builtin_amdgcn_fmed3f(r3, -440.f, 440.f),
                            c4 = __builtin_amdgcn_fmed3f(r4, -440.f, 440.f), c5 = __builtin_amdgcn_fmed3f(r5, -440.f, 440.f), c6 = __builtin_amdgcn_fmed3f(r6, -440.f, 440.f), c7 = __builtin_amdgcn_fmed3f(r7, -440.f, 440.f);
                int q0 = __builtin_amdgcn_cvt_pk_fp8_f32(c0, c1, 0, false); q0 = __builtin_amdgcn_cvt_pk_fp8_f32(c2, c3, q0, true); int q1 = __builtin_amdgcn_cvt_pk_fp8_f32(c4, c5, 0, false); q1 = __builtin_amdgcn_cvt_pk_fp8_f32(c6, c7, q1, true);
                wq[bj].x = (unsigned)q0; wq[bj].y = (unsigned)q1; }
            *(v4u*)(MQ + ro) = pair16(wq[0], wq[1]); }
#undef EPROJ_LOAD
    } };
struct EpiOut { static constexpr int NST = 16; static constexpr int ID = 2; static constexpr bool PREFETCH = false; static constexpr bool PERM = true;
    const float* xin32; bf16* xb; const float* g1; bool in32;
    __device__ __forceinline__ void operator()(const pg8::f32x4 (&acc)[2][2][4][2], const pg8::Unit& u, int wr, int wc, int fr, int fq) const {
        const int b = (u.pm * 256) >> 12, col0 = u.pn * 256 + wc * 32 + 8 * fq;
        f32x4 gv[2][2];
#pragma unroll
        for (int bj = 0; bj < 2; ++bj)
#pragma unroll
            for (int n = 0; n < 2; ++n) gv[bj][n] = *(const f32x4*)(g1 + (size_t)b * 6144 + col0 + bj * 128 + n * 4) * (1.0f / (M_SCALE * WGU_SCALE));
        const size_t rowi = (size_t)(u.pm * 256 + wr * 64 + fr);
#define EOUT_ROW(gi) (rowi + (size_t)(((gi) >> 2) * 128 + ((gi) & 3) * 16))
#define EOUT_STORE(gi, X0, X1, bj) do { const f32x4 r0_ = (X0) + gv[bj][0] * acc[(gi) >> 2][bj][(gi) & 3][0], r1_ = (X1) + gv[bj][1] * acc[(gi) >> 2][bj][(gi) & 3][1]; \
            v4u w_; w_.x = pg8::cvt_pk_bf16(r0_.x, r0_.y); w_.y = pg8::cvt_pk_bf16(r0_.z, r0_.w); w_.z = pg8::cvt_pk_bf16(r1_.x, r1_.y); w_.w = pg8::cvt_pk_bf16(r1_.z, r1_.w); *(v4u*)(xb + EOUT_ROW(gi) * XP + col0 + (bj) * 128) = w_; } while (0)
        if (in32) {
            f32x4 xf[2][2][2];
#define EOUT_LOAD(gi, buf) do { _Pragma("unroll") for (int bj = 0; bj < 2; ++bj) _Pragma("unroll") for (int n = 0; n < 2; ++n) xf[buf][bj][n] = *(const f32x4*)(xin32 + EOUT_ROW(gi) * 1024 + col0 + bj * 128 + n * 4); } while (0)
#pragma unroll
            for (int hb = 0; hb < 4; ++hb) {
#pragma unroll
            for (int g2 = 0; g2 < 2; ++g2) EOUT_LOAD(2 * hb + g2, g2);
#pragma unroll
            for (int g2 = 0; g2 < 2; ++g2) { const int gi = 2 * hb + g2, cb = g2;
#pragma unroll
                for (int bj = 0; bj < 2; ++bj) EOUT_STORE(gi, xf[cb][bj][0], xf[cb][bj][1], bj); }
            asm volatile("" ::: "memory"); }
#undef EOUT_LOAD
        } else {
            v4u xq[8][2];
#define EOUT_LOAD(gi, buf) do { _Pragma("unroll") for (int bj = 0; bj < 2; ++bj) xq[buf][bj] = *(const v4u*)(xb + EOUT_ROW(gi) * XP + col0 + bj * 128); } while (0)
#pragma unroll
            for (int gi = 0; gi < 8; ++gi) EOUT_LOAD(gi, gi);
#pragma unroll
            for (int gi = 0; gi < 8; ++gi) { const int cb = gi;
#pragma unroll
                for (int bj = 0; bj < 2; ++bj) { const v4u q_ = xq[cb][bj];
                    const f32x4 x0 = (f32x4){bflo(q_.x), bfhi(q_.x), bflo(q_.y), bfhi(q_.y)}, x1 = (f32x4){bflo(q_.z), bfhi(q_.z), bflo(q_.w), bfhi(q_.w)};
                    EOUT_STORE(gi, x0, x1, bj); } }
#undef EOUT_LOAD
        }
#undef EOUT_STORE
#undef EOUT_ROW
    } };
struct EpiRouter { static constexpr int NST = 0; static constexpr int ID = 5; static constexpr bool PERM = false;
    float* logits;
    __device__ __forceinline__ void operator()(const pg8::f32x4 (&acc)[2][2][4][2], const pg8::Unit& u, int wr, int wc, int fr, int fq) const {
        if (wc < 2) {
#pragma unroll
            for (int ai = 0; ai < 2; ++ai)
#pragma unroll
                for (int m = 0; m < 4; ++m)
#pragma unroll
                    for (int n = 0; n < 2; ++n) *(f32x4*)(logits + (size_t)(u.pm * 256 + ai * 128 + wr * 64 + m * 16 + fr) * 64 + wc * 32 + n * 16 + 4 * fq) = acc[ai][0][m][n]; }
    } };
struct EpiGU { static constexpr int NST = 8; static constexpr int ID = 3; static constexpr bool PREFETCH = false; static constexpr bool PERM = true;
    unsigned char* act;
    __device__ __forceinline__ void operator()(pg8::f32x4 (&acc)[2][2][4][2], const pg8::Unit& u, int wr, int wc, int fr, int fq) const {
        v2u wq[2];
        const int col0 = u.pn * 128 + wc * 32 + 8 * (fq & ~1);
#pragma unroll
        for (int ai = 0; ai < 2; ++ai)
#pragma unroll
            for (int m = 0; m < 4; ++m) { const size_t row = (size_t)(u.pm * 256 + ai * 128 + wr * 64 + ((m & ~1) + (fq & 1)) * 16 + fr);
                float av[8];
#pragma unroll
                for (int n = 0; n < 2; ++n)
#pragma unroll
                    for (int i = 0; i < 4; ++i) { const float g_ = acc[ai][0][m][n][i], u_ = acc[ai][1][m][n][i];
                        const float sg = __builtin_amdgcn_rcpf((WGU_SCALE * WGU_SCALE / ACT_SCALE) + __builtin_amdgcn_exp2f(__builtin_fmaf(g_, -1.4426950408889634f / WGU_SCALE, 9.0f)));
                        av[4 * n + i] = __builtin_amdgcn_fmed3f((g_ * u_) * sg, -440.0f, 440.0f); }
                int q0 = __builtin_amdgcn_cvt_pk_fp8_f32(av[0], av[1], 0, false); q0 = __builtin_amdgcn_cvt_pk_fp8_f32(av[2], av[3], q0, true);
                int q1 = __builtin_amdgcn_cvt_pk_fp8_f32(av[4], av[5], 0, false); q1 = __builtin_amdgcn_cvt_pk_fp8_f32(av[6], av[7], q1, true);
                wq[m & 1].x = (unsigned)q0; wq[m & 1].y = (unsigned)q1;
                if (m & 1) *(v4u*)(act + row * 256 + col0) = pair16(wq[0], wq[1]); }
    } };
template <bool GATHER> struct SchedMoe { static constexpr bool EARLY_VOFF = GATHER;
    const LAS int* tab; const int* ltk; int nunits, G, c, npn_log2; unsigned rowbytes;
    __device__ __forceinline__ bool next(int i, pg8::Unit& u) const { const int L = i * G + c; if (L >= nunits) return false; const int rt = L >> npn_log2, pn = L & ((1 << npn_log2) - 1); const int e = tab[TAB_TE + rt];
        u.pm = rt; u.pn = pn; u.bt = (e << npn_log2) + pn; u.aux = e | (tab[TAB_TJ + rt] << 8); return true; }
    __device__ __forceinline__ unsigned a_off(const pg8::Unit& u, int r) const {
        if (!GATHER) return (unsigned)(u.pm * 256 + r) * rowbytes;
        return a_fin(u, r, a_raw(u, r)); }
    __device__ __forceinline__ int a_raw(const pg8::Unit& u, int r) const { const int e = u.aux & 0xff, pos = (u.aux >> 8) * 256 + r; return ltk[(size_t)(e & 63) * LCAP + (pos & (LCAP - 1))]; }
    __device__ __forceinline__ unsigned a_fin(const pg8::Unit& u, int r, int raw) const { const int e = u.aux & 0xff, pos = (u.aux >> 8) * 256 + r;
        int tok = T;
        if (e == 64) tok = pos; else if (pos < tab[TAB_CNT + e]) tok = raw & 0xffff;
        return (unsigned)tok * rowbytes; } };
constexpr int TAB_PF = TAB_TJ + MAXTILES;
static_assert(TAB_OFF + (TAB_PF + 2 * 512) * 4 <= LDS_BYTES, "epilogue side table fits");
struct EpiDown { static constexpr int NST = 0; static constexpr int ID = 4; static constexpr bool PREFETCH = true; static constexpr bool PERM = true;
    unsigned char* slots; const float* lw; const int* ltk; LAS int* tab;
    __device__ __forceinline__ void fetch(const pg8::Unit& u, int tid, float& w, int& d) const {
        if (tid < 256) { const int e = u.aux & 0xff, pos = (u.aux >> 8) * 256 + tid; w = SLOT_SCALE / (WGU_SCALE * ACT_SCALE); d = pos * NSLOT + 8;
            if (e < 64) { if (pos < tab[TAB_CNT + e]) { const int tk = ltk[(size_t)e * LCAP + pos]; w = lw[(size_t)e * LCAP + pos] * (SLOT_SCALE / (WGU_SCALE * ACT_SCALE)); d = (tk & 0xffff) * NSLOT + (tk >> 16); } else d = -1; } } }
    __device__ __forceinline__ void stash(int par, int tid, float w, int d) const { if (tid < 256) { tab[TAB_PF + par * 512 + tid] = __float_as_int(w); tab[TAB_PF + par * 512 + 256 + tid] = d; } }
    __device__ __forceinline__ void operator()(pg8::f32x4 (&acc)[2][2][4][2], const pg8::Unit& u, int wr, int wc, int fr, int fq, int par) const {
        const int col0 = u.pn * 256 + wc * 64 + 16 * fq;
        float wv[8]; int dv[8];
#pragma unroll
        for (int gi = 0; gi < 8; ++gi) { const int rl = (gi >> 2) * 128 + wr * 64 + (gi & 3) * 16 + fr; wv[gi] = __int_as_float(tab[TAB_PF + par * 512 + rl]); dv[gi] = tab[TAB_PF + par * 512 + 256 + rl]; }
#pragma unroll
        for (int gi = 0; gi < 8; ++gi) { const int ai = gi >> 2, m = gi & 3; const float w = wv[gi]; const int dst = dv[gi];
            if (dst >= 0) { v4u o;
#pragma unroll
                for (int bj = 0; bj < 2; ++bj) { f32x4 a0 = acc[ai][bj][m][0] * w, a1 = acc[ai][bj][m][1] * w;
#pragma unroll
                    for (int i = 0; i < 4; ++i) { a0[i] = __builtin_amdgcn_fmed3f(a0[i], -440.0f, 440.0f); a1[i] = __builtin_amdgcn_fmed3f(a1[i], -440.0f, 440.0f); }
                    int q0 = __builtin_amdgcn_cvt_pk_fp8_f32(a0.x, a0.y, 0, false); q0 = __builtin_amdgcn_cvt_pk_fp8_f32(a0.z, a0.w, q0, true);
                    int q1 = __builtin_amdgcn_cvt_pk_fp8_f32(a1.x, a1.y, 0, false); q1 = __builtin_amdgcn_cvt_pk_fp8_f32(a1.z, a1.w, q1, true);
                    if (bj == 0) { o.x = (unsigned)q0; o.y = (unsigned)q1; } else { o.z = (unsigned)q0; o.w = (unsigned)q1; } }
                *(v4u*)(slots + (size_t)dst * 1024 + col0) = o; } }
    } };
#ifndef PH_MASK
#define PH_MASK 0xffffffffu
#endif
#define PH(k) ((PH_MASK >> (k)) & 1u)
#ifdef PROBE
#define STAMP(idx) do { if (blockIdx.x == 0 && threadIdx.x == 0) ((unsigned long long*)(args.wsp() + WS_META))[(idx)] = __builtin_amdgcn_s_memrealtime(); } while (0)
#else
#define STAMP(idx) do {} while (0)
#endif
__global__ void __launch_bounds__(NWAVES * 64, 2) mk_fwd(Args args_unused) {
    const ArgsV args{};
    extern __shared__ __attribute__((aligned(16))) unsigned char lds_raw[];
    LAS unsigned char* lds = (LAS unsigned char*)lds_raw;
    volatile LAS unsigned* MISC = (volatile LAS unsigned*)(lds + MISC_OFF);
    const int G = gridDim.x, bx = blockIdx.x;
    const int vcu = (G % 8 == 0) ? (bx % 8) * (G / 8) + bx / 8 : bx;
    for (int u = threadIdx.x; u < (LDS_BYTES - LDSCTL_OFF) / 4; u += NWAVES * 64) ((LAS unsigned*)(lds + LDSCTL_OFF))[u] = 0u;
    __syncthreads();
    const unsigned bar_x = (unsigned)__builtin_amdgcn_readfirstlane((int)xcd_barrier_post((unsigned*)(args.wsp() + WS_CTL) + CW_BAR, MISC + 8).x);
#define xcd_barrier(dummy) do { XcdBarrier b_; b_.bar = (unsigned*)(args.wsp() + WS_CTL) + CW_BAR; { unsigned x_ = bar_x; asm volatile("" : "+s"(x_)); b_.x = x_; } b_.st = (volatile LAS unsigned*)(lds + MISC_OFF) + 8; (xcd_barrier)(b_); } while (0)
    const int NGW = G * NWAVES;
#define PHASE_IDS int tid = threadIdx.x; asm volatile("" : "+v"(tid)); const int lane = tid & 63; const int wave = __builtin_amdgcn_readfirstlane(tid >> 6); const int gw = vcu * NWAVES + wave; (void)lane; (void)gw;
#define Hb ((bf16*)(args.wsp() + WS_H))
#define H2b ((bf16*)(args.wsp() + WS_H2))
#define QKVb ((bf16*)(args.wsp() + WS_QKV))
#define Gb ((unsigned char*)(args.wsp() + WS_G))
#define MODb ((float*)(args.wsp() + WS_MOD))

    STAMP(40);
#ifdef PROBE
    if (blockIdx.x == 0 && threadIdx.x == 0) { for (int i = 64; i < 96; ++i) ((unsigned long long*)(args.wsp() + WS_META))[i] = 0ull; }
#endif
    { PHASE_IDS
    if (PH(0)) { for (int u = bx; u < 192; u += G) mod_unit(args, u, lds, tid, wave, lane); }
    if (PH(1)) convert_weights(args, 0, lds, gw, NGW, wave, lane); }
    xcd_barrier(bar);
    STAMP(41);

    for (int l = 0; l < DEPTH; ++l) {
        STAMP(l * 16 + 0);
        { PHASE_IDS
        if (PH(1) && l == 1) convert_weights(args, 1, lds, gw, NGW, wave, lane);
        if (PH(2)) { LAS float* wfl = (LAS float*)(lds + 73728); const float* wsrc = args.in[I_WIN] + (size_t)l * D * NIN + 3072;
          for (int k = tid; k < 1024; k += 512) { const f32x4 w0 = *(const f32x4*)(wsrc + (size_t)k * NIN), w1 = *(const f32x4*)(wsrc + (size_t)k * NIN + 4);
              wfl[0 * 1024 + k] = w0.x; wfl[1 * 1024 + k] = w0.y; wfl[2 * 1024 + k] = w0.z; wfl[3 * 1024 + k] = w0.w; wfl[4 * 1024 + k] = w1.x; wfl[5 * 1024 + k] = w1.y; wfl[6 * 1024 + k] = w1.z; wfl[7 * 1024 + k] = w1.w; }
          if (bx == 0 && wave < 4) ((float*)(args.wsp() + WS_GAIN))[wave * 64 + lane] = args.in[I_QNA + wave][l * 64 + lane];
          __syncthreads();
          if (l == 0) { for (int g = gw; g < T / 16; g += NGW) norm_rows<0, false>(args, l, lds, g, lane); }
          else { for (int g = gw; g < T / 16; g += NGW) norm_rows<0, true>(args, l, lds, g, lane); }
          __syncthreads(); } }
        xcd_barrier(bar);
        STAMP(l * 16 + 1);

        if (PH(3)) for (int s = bx; s < 64; s += G) { PHASE_IDS
            const float* lf = (const float*)(args.wsp() + WS_LOGF) + (size_t)s * SEQ; float* cm = (float*)(args.wsp() + WS_CUM) + (size_t)s * SEQ;
            LAS float* wtot = (LAS float*)lds;
            const f32x4 a0 = *(const f32x4*)(lf + 8 * tid), a1 = *(const f32x4*)(lf + 8 * tid + 4);
            float v[8]; v[0] = a0.x; v[1] = v[0] + a0.y; v[2] = v[1] + a0.z; v[3] = v[2] + a0.w; v[4] = v[3] + a1.x; v[5] = v[4] + a1.y; v[6] = v[5] + a1.z; v[7] = v[6] + a1.w;
            float inc = v[7];
#pragma unroll
            for (int o = 1; o < 64; o <<= 1) { const float t = __shfl_up(inc, o); if (lane >= o) inc += t; }
            if (lane == 63) wtot[wave] = inc;
            __syncthreads();
            float base = inc - v[7];
            for (int w = 0; w < wave; ++w) base += wtot[w];
            *(f32x4*)(cm + 8 * tid) = (f32x4){v[0] + base, v[1] + base, v[2] + base, v[3] + base};
            *(f32x4*)(cm + 8 * tid + 4) = (f32x4){v[4] + base, v[5] + base, v[6] + base, v[7] + base};
            __syncthreads();
        }
        if (PH(4)) { EpiIn E{QKVb, Gb, (const float*)(args.wsp() + WS_GAIN)};
#ifdef STAG_PB
          { const unsigned long long t0_ = __builtin_amdgcn_s_memrealtime(); const unsigned long long d_ = (unsigned long long)((bx >> 3) & 7) * STAG_PB;
            while (__builtin_amdgcn_s_memrealtime() - t0_ < d_) __builtin_amdgcn_s_sleep(4); }
#endif
          { SchedDense S; S.o.init(T / 256, 20, G, bx); S.rowbytes = 1024; S.pn_map = 0;
            pg8::gemm_phase<EpiIn, SchedDense, true>(lds, args.wsp() + WS_HQ, (const bf16*)(args.wsp() + WS_WING), 512, S, E); } }
        xcd_barrier(bar);
        STAMP(l * 16 + 2);

        if (PH(5)) for (int v = vcu; v < 256; v += G) {
            const int bh = v >> 2, s = v & 3, b = bh >> 3, h = bh & 7;
            const float* cum = (const float*)(args.wsp() + WS_CUM); const float* rel = args.in[I_REL] + (size_t)l * 8 * 257;
            __syncthreads(); fox::prep_kaug(cum + (size_t)bh * SEQ, (char*)lds_raw); __syncthreads();
            for (int i = 0; i < 4; ++i) { const int qb = (i == 0) ? s : (i == 1) ? 7 - s : (i == 2) ? 8 + s : 15 - s;
                fox::attn_unit<8>(b, h, qb, (const fox::bf16*)(QKVb + 3 * QKV_STRIDE), (const fox::bf16*)(QKVb + 4 * QKV_STRIDE), (const fox::bf16*)(QKVb + 5 * QKV_STRIDE), (fox::bf16*)(args.wsp() + WS_H + (48u << 20)), cum + (size_t)bh * SEQ, (char*)lds_raw); }
#ifdef PROBE_DUPBAND
            for (int i = 0; i < 4; ++i) att::attn_unit<1>(b, h, 4 * s + i, QKVb, QKVb + 1 * QKV_STRIDE, QKVb + 2 * QKV_STRIDE, (bf16*)(args.wsp() + WS_H), cum, rel, lds);
#endif
            for (int i = 0; i < 4; ++i) att::attn_unit<1>(b, h, 4 * s + i, QKVb, QKVb + 1 * QKV_STRIDE, QKVb + 2 * QKV_STRIDE, (bf16*)(args.wsp() + WS_H + (32u << 20)), cum, rel, lds);
        }
        __syncthreads();
        xcd_barrier(bar);
        STAMP(l * 16 + 3);

        if (PH(6)) { SchedProj S; S.o.init(T / 256, 4, G, bx); S.rowbytes = 512; S.delta = (unsigned)(16u << 20);
          EpiProj E{Gb, (unsigned char*)(args.wsp() + WS_H), (unsigned char*)(args.wsp() + WS_MQ)};
          pg8::gemm_phase<EpiProj, SchedProj, true>(lds, args.wsp() + WS_H + (32u << 20), (const bf16*)(args.wsp() + WS_WPROJ), 256, S, E); }
        xcd_barrier(bar);
        STAMP(l * 16 + 4);

        if (PH(7)) { SchedDense S; S.o.init(T / 256, 4, G, bx); S.rowbytes = 1024; S.pn_map = 0;
          EpiOut E{args.in[I_X], (bf16*)args.outp(), MODb + (size_t)l * 8 * 6144 + 2048, l == 0};
          pg8::gemm_phase<EpiOut, SchedDense, true>(lds, args.wsp() + WS_MQ, (const bf16*)(args.wsp() + WS_WOUT), 512, S, E); }
        xcd_barrier(bar);
        STAMP(l * 16 + 5);

        if (PH(8)) for (int blk = vcu; blk < 256; blk += G) { PHASE_IDS moe_front(args, l, blk, lds, tid, wave, lane); }
        if (bx == 0) { PHASE_IDS if (tid < 256) ((unsigned*)(args.wsp() + WS_H2Q + (size_t)T * D))[tid] = 0u; }
        xcd_barrier(bar);
        STAMP(l * 16 + 6); STAMP(l * 16 + 7); STAMP(l * 16 + 8); STAMP(l * 16 + 9);

        {   int ntl; { PHASE_IDS ntl = moe_table(args, l, lds, tid); }
            LAS int* tab = (LAS int*)(lds + TAB_OFF);
            if (PH(13)) { SchedMoe<true> S{tab, (const int*)(args.wsp() + WS_LTK), ntl * 2, G, vcu, 1, 1024u};
              EpiGU E{(unsigned char*)(args.wsp() + WS_ACT)};
              pg8::gemm_phase<EpiGU, SchedMoe<true>, true>(lds, args.wsp() + WS_H2Q, (const bf16*)(args.wsp() + WS_WGU), 512, S, E); }
            xcd_barrier(bar);
            STAMP(l * 16 + 10);
            if (PH(14)) { SchedMoe<false> S{tab, nullptr, ntl * 4, G, vcu, 2, 256u};
              EpiDown E{(unsigned char*)(args.wsp() + WS_SLOT), (const float*)(args.wsp() + WS_LW), (const int*)(args.wsp() + WS_LTK), tab};
              int kdn = 128; asm volatile("" : "+s"(kdn));
              pg8::gemm_phase<EpiDown, SchedMoe<false>, true>(lds, args.wsp() + WS_ACT, (const bf16*)(args.wsp() + WS_WD), kdn, S, E); }
            xcd_barrier(bar);
            STAMP(l * 16 + 11);
            STAMP(l * 16 + 12);
            STAMP(l * 16 + 13);
        }
    }
    if (PH(12)) { PHASE_IDS reduce_rows(args, DEPTH - 1, 0, T, gw, NGW, lane); }
#ifdef PROBE
    if (blockIdx.x == 0 && threadIdx.x == 0) {
        const unsigned long long* ts = (const unsigned long long*)(args.wsp() + WS_META);
        const unsigned long long tend = __builtin_amdgcn_s_memrealtime();
        unsigned long long dA = 0, dB = 0;
        if (PROBE_A0 == 99) dA = 0; else if (PROBE_A0 == 50) dA = tend - ts[29]; else if (PROBE_A0 >= 40) dA = ts[PROBE_A1] - ts[PROBE_A0]; else for (int l = 0; l < DEPTH; ++l) dA += ts[l * 16 + PROBE_A1] - ts[l * 16 + PROBE_A0];
        if (PROBE_B0 >= 60) dB = ts[64 + (PROBE_B0 - 60) * 4 + PROBE_B1]; else if (PROBE_B0 == 50) dB = tend - ts[29]; else if (PROBE_B0 >= 40) dB = ts[PROBE_B1] - ts[PROBE_B0]; else for (int l = 0; l < DEPTH; ++l) dB += ts[l * 16 + PROBE_B1] - ts[l * 16 + PROBE_B0];
        asm volatile("s_waitcnt vmcnt(0)" ::: "memory");
        args.outp()[0] = 8.0f + ((float)dB * 0.01f - (PROBE_A0 == 99 ? (float)PROBE_A1 : 0.f)) * (1.0f / PROBE_BSCALE);
        while (__builtin_amdgcn_s_memrealtime() - tend < dA) __builtin_amdgcn_s_sleep(8);
    }
#endif
}

#undef xcd_barrier
#undef Hb
#undef H2b
#undef QKVb
#undef Gb
#undef MODb
extern "C" void kernel_launch(void* const* d_in, const int* in_sizes, int n_in, void* d_out, int out_size, void* d_ws, size_t ws_size, hipStream_t stream) {
    static int grid = 0;
    if (grid == 0) {
        if (n_in != 24 || out_size != T * D || ws_size < WS_END) { fprintf(stderr, "kernel_launch: unexpected shapes (n_in %d, out %d, ws %zu)\n", n_in, out_size, ws_size); grid = -1; return; }
        int dev = 0, cus = 0, per_cu = 0;
        if (hipGetDevice(&dev) != hipSuccess || hipDeviceGetAttribute(&cus, hipDeviceAttributeMultiprocessorCount, dev) != hipSuccess) { grid = -1; return; }
        if (hipFuncSetAttribute((const void*)mk_fwd, hipFuncAttributeMaxDynamicSharedMemorySize, LDS_BYTES) != hipSuccess) { fprintf(stderr, "kernel_launch: hipFuncSetAttribute failed\n"); grid = -1; return; }
        if (hipOccupancyMaxActiveBlocksPerMultiprocessor(&per_cu, (const void*)mk_fwd, NWAVES * 64, LDS_BYTES) != hipSuccess || per_cu < 1) fprintf(stderr, "kernel_launch: occupancy query reports %d\n", per_cu);
        (void)hipGetLastError();
        grid = cus;
    }
    if (grid < 0) return;
    if (hipMemsetAsync((char*)d_ws + WS_CTL, 0, CTL_ZERO_BYTES, stream) != hipSuccess) return;
    Args a{};
    for (int i = 0; i < 24; ++i) a.in[i] = (const float*)d_in[i];
    a.out = (float*)d_out; a.ws = (unsigned char*)d_ws;
    hipLaunchKernelGGL(mk_fwd, dim3(grid), dim3(NWAVES * 64), LDS_BYTES, stream, a);
}
```
